# Optimizing an MI355X kernel written in HIP

```python
import math
import jax, jax.numpy as jnp
from jax import lax
import numpy as np

D_MODEL = 1024
BATCH = 8
SEQ = 2048
DEPTH = 2

N_BRANCH = 3
BRANCH_WIDTH = 512
ATTN_Q_HEADS = 8
ATTN_KV_HEADS = 2
ATTN_Q_PER_KV = ATTN_Q_HEADS // ATTN_KV_HEADS
ATTN_HEAD_DIM = 64
ATTN_WINDOW = 128
ATTN_BLOCK = 128
ROPE_DIM = ATTN_HEAD_DIM // 4
ROPE_THETA = 500000.0
DN_HEADS = 8
DN_KEY_DIM = 64
DN_VALUE_DIM = 64
DN_CONV = 4
DN_CHUNK = 64
DN_QKV_WIDTH = DN_HEADS * (2 * DN_KEY_DIM + DN_VALUE_DIM)
RET_HEADS = 4
RET_KEY_DIM = 64
RET_VALUE_DIM = 128
RET_CHUNK = 64
RET_THETA = 10000.0
D_FF = 2816
N_MOD = 9
EPS = 1e-6
NEG_INF = -1e30

IN_SIZES = (
    ATTN_Q_HEADS * ATTN_HEAD_DIM,
    ATTN_KV_HEADS * ATTN_HEAD_DIM,
    ATTN_KV_HEADS * ATTN_HEAD_DIM,
    DN_QKV_WIDTH,
    DN_HEADS,
    DN_HEADS,
    DN_HEADS * DN_VALUE_DIM,
    RET_HEADS * RET_KEY_DIM,
    RET_HEADS * RET_KEY_DIM,
    RET_HEADS * RET_VALUE_DIM,
    RET_HEADS * RET_VALUE_DIM,
    N_BRANCH * D_MODEL,
)
N_IN = 768 + 2064 + 1536 + 3 * D_MODEL

kernel_name = 'hybrid_gated_parallel_mixer'


def _split_columns(t, sizes):
    out, start = [], 0
    for n in sizes:
        out.append(t[..., start:start + n])
        start += n
    return out


def rms_norm(x):
    xf = x.astype(jnp.float32)
    y = xf * lax.rsqrt(jnp.mean(xf * xf, axis=-1, keepdims=True) + EPS)
    return y.astype(x.dtype)


def l2_norm(x):
    xf = x.astype(jnp.float32)
    return (xf * lax.rsqrt(jnp.sum(xf * xf, axis=-1, keepdims=True) + EPS)).astype(x.dtype)


def modulate(x, gain, shift, scale):
    return rms_norm(x) * gain * (1.0 + scale) + shift


def swiglu_ffn(u, w13, w2):
    gate, up = jnp.split(u @ w13, 2, axis=-1)
    return (jax.nn.silu(gate) * up) @ w2


def partial_rope(x, pos):
    half = ROPE_DIM // 2
    inv_freq = ROPE_THETA ** (-jnp.arange(0, ROPE_DIM, 2, dtype=jnp.float32) / ROPE_DIM)
    phase = pos[:, None] * inv_freq[None, :]
    cos = jnp.cos(phase)[None, :, None, :].astype(x.dtype)
    sin = jnp.sin(phase)[None, :, None, :].astype(x.dtype)
    x1, x2, rest = x[..., :half], x[..., half:ROPE_DIM], x[..., ROPE_DIM:]
    return jnp.concatenate([x1 * cos - x2 * sin, x2 * cos + x1 * sin, rest], axis=-1)


def retnet_rotate(x, pos):
    dk = x.shape[-1]
    angle = 1.0 / (RET_THETA ** jnp.linspace(0.0, 1.0, dk // 2, dtype=jnp.float32))
    angle = jnp.repeat(angle, 2)
    phase = pos[:, None] * angle[None, :]
    cos = jnp.cos(phase)[None, :, None, :].astype(x.dtype)
    sin = jnp.sin(phase)[None, :, None, :].astype(x.dtype)
    rot = jnp.stack([-x[..., 1::2], x[..., 0::2]], axis=-1).reshape(x.shape)
    return x * cos + rot * sin


def causal_depthwise_conv(x, w):
    k = w.shape[0]
    return lax.conv_general_dilated(
        x, w[:, None, :].astype(x.dtype), window_strides=(1,), padding=[(k - 1, 0)],
        dimension_numbers=('NWC', 'WIO', 'NWC'), feature_group_count=x.shape[-1])


def sliding_window_attention(q, k, v, sinks):
    b, s = q.shape[0], q.shape[1]
    nb = s // ATTN_BLOCK
    qb = q.reshape(b, nb, ATTN_BLOCK, ATTN_KV_HEADS, ATTN_Q_PER_KV, ATTN_HEAD_DIM)

    def band(t):
        tb = t.reshape(b, nb, ATTN_BLOCK, ATTN_KV_HEADS, ATTN_HEAD_DIM)
        prev = jnp.pad(tb, ((0, 0), (1, 0), (0, 0), (0, 0), (0, 0)))[:, :-1]
        return jnp.concatenate([prev, tb], axis=2)

    kb, vb = band(k), band(v)
    logits = jnp.einsum('bnqgrd,bnkgd->bngrqk', qb, kb).astype(jnp.float32) * (ATTN_HEAD_DIM ** -0.5)
    qi = jnp.arange(ATTN_BLOCK)[:, None] + ATTN_BLOCK
    kj = jnp.arange(2 * ATTN_BLOCK)[None, :]
    in_window = (kj <= qi) & (kj > qi - ATTN_WINDOW)
    key_abs = jnp.arange(nb)[:, None, None] * ATTN_BLOCK + kj[None] - ATTN_BLOCK
    valid = in_window[None] & (key_abs >= 0)
    logits = jnp.where(valid[None, :, None, None], logits, NEG_INF)
    sink = sinks.astype(jnp.float32).reshape(ATTN_KV_HEADS, ATTN_Q_PER_KV)[None, None, :, :, None, None]
    sink = jnp.broadcast_to(sink, logits.shape[:-1] + (1,))
    probs = jax.nn.softmax(jnp.concatenate([logits, sink], axis=-1), axis=-1)[..., :-1]
    out = jnp.einsum('bngrqk,bnkgd->bnqgrd', probs.astype(v.dtype), vb)
    return out.reshape(b, s, ATTN_Q_HEADS * ATTN_HEAD_DIM)


def gated_delta_rule_chunked(q, k, v, log_decay, beta):
    b, s, h, dk = q.shape
    dv = v.shape[-1]
    c = DN_CHUNK
    nc = s // c
    f32 = jnp.float32

    def to_chunks(t):
        return t.astype(f32).reshape(b, nc, c, h, -1).transpose(0, 3, 1, 2, 4)

    q = to_chunks(q) * (dk ** -0.5)
    k = to_chunks(k)
    v = to_chunks(v)
    g = jnp.cumsum(to_chunks(log_decay[..., None])[..., 0], axis=-1)
    beta = to_chunks(beta[..., None])
    causal = jnp.tril(jnp.ones((c, c), dtype=bool))
    strict = jnp.tril(jnp.ones((c, c), dtype=bool), k=-1)
    diff = g[..., :, None] - g[..., None, :]
    decay = jnp.where(causal, jnp.exp(jnp.where(causal, diff, 0.0)), 0.0)
    k_beta = k * beta
    v_beta = v * beta
    lower = jnp.where(strict, jnp.einsum('bhnid,bhnjd->bhnij', k_beta, k) * decay, 0.0)
    unit_lower = lower + jnp.eye(c, dtype=f32)
    rhs = jnp.concatenate([v_beta, k_beta * jnp.exp(g)[..., None]], axis=-1)
    sol = lax.linalg.triangular_solve(unit_lower, rhs, left_side=True, lower=True, unit_diagonal=True)
    u_c, w_c = sol[..., :dv], sol[..., dv:]
    intra = jnp.where(causal, jnp.einsum('bhnid,bhnjd->bhnij', q, k) * decay, 0.0)
    q_decayed = q * jnp.exp(g)[..., None]
    k_to_end = k * jnp.exp(g[..., -1:] - g)[..., None]
    chunk_decay = jnp.exp(g[..., -1])

    def step(state, xs):
        u_i, w_i, intra_i, qd_i, kt_i, dec_i = xs
        v_new = u_i - jnp.einsum('bhik,bhkv->bhiv', w_i, state)
        out = jnp.einsum('bhik,bhkv->bhiv', qd_i, state) + jnp.einsum('bhij,bhjv->bhiv', intra_i, v_new)
        state = state * dec_i[..., None, None] + jnp.einsum('bhik,bhiv->bhkv', kt_i, v_new)
        return state, out

    xs = tuple(jnp.moveaxis(t, 2, 0) for t in (u_c, w_c, intra, q_decayed, k_to_end, chunk_decay))
    _, out = lax.scan(step, jnp.zeros((b, h, dk, dv), f32), xs)
    return out.transpose(1, 0, 3, 2, 4).reshape(b, s, h, dv)


def retention_chunked(q, k, v):
    b, s, h, dk = q.shape
    dv = v.shape[-1]
    c = RET_CHUNK
    nc = s // c
    f32 = jnp.float32

    def to_chunks(t):
        return t.astype(f32).reshape(b, nc, c, h, -1).transpose(0, 3, 1, 2, 4)

    q, k, v = to_chunks(q), to_chunks(k), to_chunks(v)
    log_gamma = jnp.log1p(-jnp.exp2(-5.0 - jnp.arange(h, dtype=f32)))
    pos = jnp.arange(c, dtype=f32)
    causal = jnp.tril(jnp.ones((c, c), dtype=bool))
    diff = jnp.where(causal, pos[:, None] - pos[None, :], 0.0)
    decay = jnp.where(causal, jnp.exp(log_gamma[:, None, None] * diff), 0.0)
    scores = jnp.einsum('bhnid,bhnjd->bhnij', q, k) * decay[None, :, None]
    intra_out = jnp.einsum('bhnij,bhnjv->bhniv', scores, v)
    q_decayed = q * jnp.exp(log_gamma[:, None] * (pos + 1.0))[None, :, None, :, None]
    k_to_end = k * jnp.exp(log_gamma[:, None] * (c - 1.0 - pos))[None, :, None, :, None]
    chunk_kv = jnp.einsum('bhnjd,bhnjv->bhndv', k_to_end, v)
    chunk_decay = jnp.exp(log_gamma * c)[None, :, None, None]

    def step(state, xs):
        qd_i, kv_i = xs
        out = jnp.einsum('bhik,bhkv->bhiv', qd_i, state)
        return state * chunk_decay + kv_i, out

    _, inter = lax.scan(step, jnp.zeros((b, h, dk, dv), f32),
                        (jnp.moveaxis(q_decayed, 2, 0), jnp.moveaxis(chunk_kv, 2, 0)))
    out = intra_out + jnp.moveaxis(inter, 0, 2)
    return out.transpose(0, 2, 3, 1, 4).reshape(b, s, h, dv)


def hybrid_mixer(u, w_in, attn_q_norm, attn_k_norm, attn_sinks, dn_conv, dn_a_log, dn_dt_bias,
                 dn_out_norm, w_branch, w_out):
    b, s, _ = u.shape
    f32 = jnp.float32
    proj = u @ w_in
    (a_q, a_k, a_v, d_qkv, d_a, d_b, d_z, r_q, r_k, r_v, r_g, gate_logits) = _split_columns(proj, IN_SIZES)
    pos = jnp.arange(s, dtype=f32)

    q = a_q.reshape(b, s, ATTN_Q_HEADS, ATTN_HEAD_DIM)
    k = a_k.reshape(b, s, ATTN_KV_HEADS, ATTN_HEAD_DIM)
    v = a_v.reshape(b, s, ATTN_KV_HEADS, ATTN_HEAD_DIM)
    q = partial_rope(rms_norm(q) * attn_q_norm, pos)
    k = partial_rope(rms_norm(k) * attn_k_norm, pos)
    out_a = sliding_window_attention(q, k, v, attn_sinks)

    qkv = jax.nn.silu(causal_depthwise_conv(d_qkv, dn_conv))
    dq, dk_, dv_ = _split_columns(qkv, (DN_HEADS * DN_KEY_DIM, DN_HEADS * DN_KEY_DIM, DN_HEADS * DN_VALUE_DIM))
    dq = l2_norm(dq.reshape(b, s, DN_HEADS, DN_KEY_DIM))
    dk_ = l2_norm(dk_.reshape(b, s, DN_HEADS, DN_KEY_DIM))
    dv_ = dv_.reshape(b, s, DN_HEADS, DN_VALUE_DIM)
    log_decay = -jnp.exp(dn_a_log.astype(f32)) * jax.nn.softplus(d_a.astype(f32) + dn_dt_bias.astype(f32))
    beta = jax.nn.sigmoid(d_b.astype(f32))
    o_b = gated_delta_rule_chunked(dq, dk_, dv_, log_decay, beta).astype(u.dtype)
    o_b = rms_norm(o_b) * dn_out_norm * jax.nn.silu(d_z.reshape(b, s, DN_HEADS, DN_VALUE_DIM))
    out_b = o_b.reshape(b, s, DN_HEADS * DN_VALUE_DIM)

    rq = retnet_rotate(r_q.reshape(b, s, RET_HEADS, RET_KEY_DIM), pos)
    rk = retnet_rotate(r_k.reshape(b, s, RET_HEADS, RET_KEY_DIM), pos) * (RET_KEY_DIM ** -0.5)
    rv = r_v.reshape(b, s, RET_HEADS, RET_VALUE_DIM)
    o_c = rms_norm(retention_chunked(rq, rk, rv).astype(u.dtype))
    out_c = o_c.reshape(b, s, RET_HEADS * RET_VALUE_DIM) * jax.nn.silu(r_g)

    branches = jnp.stack([out_a, out_b, out_c], axis=2)
    per_branch = jnp.einsum('bsgi,gid->bsgd', branches, w_branch)
    gates = jax.nn.sigmoid(gate_logits.reshape(b, s, N_BRANCH, D_MODEL))
    merged = jnp.sum(gates * per_branch, axis=2)
    return merged @ w_out


def setup_inputs(seed: int = 0) -> dict:
    key = jax.random.key(seed)
    ks = jax.random.split(key, 24)
    f32 = jnp.float32
    L, D = DEPTH, D_MODEL

    def normal(k, shape, scale):
        return jax.random.normal(k, shape, f32) * scale

    def gain(k, shape):
        return 1.0 + 0.1 * jax.random.normal(k, shape, f32)

    dt = jnp.exp(jax.random.uniform(ks[13], (L, DN_HEADS), f32, minval=math.log(1e-3), maxval=math.log(1e-1)))
    return {
        'x': normal(ks[0], (BATCH, SEQ, D), 1.0),
        'c': normal(ks[1], (BATCH, D), 1.0),
        'w_mod': normal(ks[2], (L, D, N_MOD * D), 0.5 * D ** -0.5),
        'b_mod': normal(ks[3], (L, N_MOD * D), 0.02),
        'ffn1_norm': gain(ks[4], (L, D)),
        'ffn1_w13': normal(ks[5], (L, D, 2 * D_FF), D ** -0.5),
        'ffn1_w2': normal(ks[6], (L, D_FF, D), D_FF ** -0.5),
        'mix_norm': gain(ks[7], (L, D)),
        'w_in': normal(ks[8], (L, D, N_IN), D ** -0.5),
        'attn_q_norm': gain(ks[9], (L, ATTN_HEAD_DIM)),
        'attn_k_norm': gain(ks[10], (L, ATTN_HEAD_DIM)),
        'attn_sinks': normal(ks[11], (L, ATTN_Q_HEADS), 1.0),
        'dn_conv': normal(ks[12], (L, DN_CONV, DN_QKV_WIDTH), DN_CONV ** -0.5),
        'dn_a_log': jnp.log(jax.random.uniform(ks[14], (L, DN_HEADS), f32, minval=1.0, maxval=16.0)),
        'dn_dt_bias': jnp.log(jnp.expm1(dt)),
        'dn_out_norm': gain(ks[15], (L, DN_VALUE_DIM)),
        'w_branch': normal(ks[16], (L, N_BRANCH, BRANCH_WIDTH, D), BRANCH_WIDTH ** -0.5),
        'w_out': normal(ks[17], (L, D, D), D ** -0.5),
        'ffn2_norm': gain(ks[18], (L, D)),
        'ffn2_w13': normal(ks[19], (L, D, 2 * D_FF), D ** -0.5),
        'ffn2_w2': normal(ks[20], (L, D_FF, D), D_FF ** -0.5),
    }


def reference(x, c, w_mod, b_mod, ffn1_norm, ffn1_w13, ffn1_w2, mix_norm, w_in, attn_q_norm,
              attn_k_norm, attn_sinks, dn_conv, dn_a_log, dn_dt_bias, dn_out_norm, w_branch, w_out,
              ffn2_norm, ffn2_w13, ffn2_w2):
    b = x.shape[0]
    cond = jax.nn.silu(c)
    for layer in range(DEPTH):
        mod = (cond @ w_mod[layer] + b_mod[layer]).reshape(b, N_MOD, 1, D_MODEL)
        u1 = modulate(x, ffn1_norm[layer], mod[:, 0], mod[:, 1])
        x = x + 0.5 * mod[:, 2] * swiglu_ffn(u1, ffn1_w13[layer], ffn1_w2[layer])
        u2 = modulate(x, mix_norm[layer], mod[:, 3], mod[:, 4])
        x = x + mod[:, 5] * hybrid_mixer(u2, w_in[layer], attn_q_norm[layer], attn_k_norm[layer],
                                         attn_sinks[layer], dn_conv[layer], dn_a_log[layer],
                                         dn_dt_bias[layer], dn_out_norm[layer], w_branch[layer],
                                         w_out[layer])
        u3 = modulate(x, ffn2_norm[layer], mod[:, 6], mod[:, 7])
        x = x + 0.5 * mod[:, 8] * swiglu_ffn(u3, ffn2_w13[layer], ffn2_w2[layer])
    return x
```

```cpp
#include <hip/hip_runtime.h>
#include <hip/hip_cooperative_groups.h>
#include <cstdio>
#include <cstdint>
namespace pg8 {
#define PG8_LAS __attribute__((address_space(3)))
typedef unsigned short bf16_t;
typedef short bf16x8 __attribute__((ext_vector_type(8)));
typedef float f32x4 __attribute__((ext_vector_type(4)));
typedef unsigned u32x4 __attribute__((ext_vector_type(4)));
constexpr int BM = 256, BK = 64, HALF = 128, HTB = HALF * BK * 2  , STAGE_BYTES = 8 * HTB, NXCD = 8, WGM = 8;

__host__ __device__ __forceinline__ int lds_byte(int r, int c) { const int st = (r >> 4) * 2 + (c >> 5), rr = r & 15, cc = c & 31, ob = rr * 64 + cc * 2; return st * 1024 + (ob ^ (((ob >> 9) & 1) << 5)); }
__host__ __device__ __forceinline__ void stage_rc(int b, int& R, int& C) { const int st = b / 1024, sb = b % 1024, swz = sb ^ (((sb >> 9) & 1) << 5); R = (st >> 1) * 16 + swz / 64; C = (st & 1) * 32 + (swz % 64) / 2; }
__host__ __device__ __forceinline__ int perm32(int rho) { const int n = rho >> 4, i = rho & 15; return 8 * (i >> 2) + 4 * n + (i & 3); }

struct Unit { int pm, pn; };
struct Gemm { const bf16_t* A; const bf16_t* Bt; int M, N, K; };

struct StaticOrder {
    int nM, nN, nwg, G, c;
    __host__ __device__ void init(int M, int N, int G_, int c_) { nM = M / BM; nN = N / BM; nwg = nM * nN; G = G_; c = c_; }
    __host__ __device__ bool next(int i, Unit& u) const {
        const long L = (long)i * G + c; if (L >= nwg) return false;
        int wgid = (int)L; { const int q = nwg / NXCD, r = nwg % NXCD, xcd = wgid % NXCD, off = wgid / NXCD; wgid = (xcd < r ? xcd * (q + 1) : r * (q + 1) + (xcd - r) * q) + off; }
        const int nig = WGM * nN, gid = wgid / nig, fm = gid * WGM, gsz = (nM - fm) < WGM ? (nM - fm) : WGM;
        u.pm = fm + ((wgid % nig) % gsz); u.pn = (wgid % nig) / gsz; return true;
    }
    __device__ __forceinline__ void a_ready(const Unit&) const {}
    __device__ __forceinline__ void done(const Unit&) const {}
};

__device__ __forceinline__ unsigned cvt_pk_bf16(float lo, float hi) { unsigned r; asm volatile("v_cvt_pk_bf16_f32 %0, %1, %2" : "=v"(r) : "v"(lo), "v"(hi)); return r; }
typedef float f32x2 __attribute__((ext_vector_type(2)));
template <class Epi, class Sched, bool ALIGN_EPI = false, bool SP2 = false>
__device__ __forceinline__ void gemm_phase(PG8_LAS unsigned char* lds, const Gemm g, const Sched& S, const Epi& E, const int tid) {
    const int wid = __builtin_amdgcn_readfirstlane(tid >> 6), lane = tid & 63, wr = wid >> 2, wc = wid & 3, fr = lane & 15, fq = lane >> 4;
    const int K = g.K, nt = K / BK; float zz = 0.f; asm volatile("" : "+v"(zz));
    unsigned voffA[2], voffB[2];
#pragma unroll
    for (int i = 0; i < 2; ++i) { int R, C; stage_rc(tid * 16 + i * 8192, R, C); const int Rb = Epi::PERM ? ((R & ~31) + perm32(R & 31)) : R;
        voffA[i] = (unsigned)(R * K + C) * 2u; voffB[i] = (unsigned)(Rb * K + C) * 2u; }
    const size_t kstep = (size_t)(BK * 2);
    const size_t hstep = (size_t)HALF * K * 2;
    const size_t tstep = 2 * hstep;
    const unsigned ldsw = (unsigned)wid * 1024u;
    const int aoff = lds_byte(wr * 64 + fr, fq * 8), boff = lds_byte(wc * 32 + fr, fq * 8);
#define PG8_SA(b, h) (((b) * 2 + (h)) * HTB)
#define PG8_SB(b, h) ((4 + (b) * 2 + (h)) * HTB)
#define PG8_STAGE(bufoff, gbase, voff) do { _Pragma("unroll") for (int _i = 0; _i < 2; ++_i) \
        __builtin_amdgcn_global_load_lds((const unsigned*)((const char*)(gbase) + (voff)[_i]), (PG8_LAS unsigned*)(lds + (bufoff) + ldsw + _i * 8192), 16, 0, 0); } while (0)
#define PG8_LDA(dst, b, h) do { _Pragma("unroll") for (int m = 0; m < 4; ++m) _Pragma("unroll") for (int k = 0; k < 2; ++k) dst[m][k] = *(const PG8_LAS bf16x8*)(lds + PG8_SA(b, h) + aoff + m * 2048 + k * 1024); } while (0)
#define PG8_LDB(dst, b, h) do { _Pragma("unroll") for (int n = 0; n < 2; ++n) _Pragma("unroll") for (int k = 0; k < 2; ++k) dst[n][k] = *(const PG8_LAS bf16x8*)(lds + PG8_SB(b, h) + boff + n * 2048 + k * 1024); } while (0)
#define PG8_MMA(ai, bj, At, Bt) do { __builtin_amdgcn_s_setprio(1); _Pragma("unroll") for (int m = 0; m < 4; ++m) _Pragma("unroll") for (int n = 0; n < 2; ++n) _Pragma("unroll") for (int k = 0; k < 2; ++k) \
        acc[ai][bj][m][n] = __builtin_amdgcn_mfma_f32_16x16x32_bf16(Bt[n][k], At[m][k], acc[ai][bj][m][n], 0, 0, 0); __builtin_amdgcn_s_setprio(0); } while (0)
#define PG8_WAIT_V(n) asm volatile("s_waitcnt vmcnt(" #n ")" ::: "memory")
#define PG8_WAIT_L(n) asm volatile("s_waitcnt lgkmcnt(" #n ")" ::: "memory")
#define PG8_BAR __builtin_amdgcn_s_barrier()
#define PG8_SCHED __builtin_amdgcn_sched_barrier(0)
    Unit cur, nxt; int ui = 0;
    if (!S.next(0, cur)) return;
    f32x4 acc[2][2][4][2];
#pragma unroll
    for (int a = 0; a < 2; ++a)
#pragma unroll
        for (int b = 0; b < 2; ++b)
#pragma unroll
            for (int m = 0; m < 4; ++m)
#pragma unroll
                for (int n = 0; n < 2; ++n) acc[a][b][m][n] = (f32x4){zz, zz, zz, zz};
    bf16x8 At[4][2], B0[2][2], B1[2][2];
    const char* cA = (const char*)g.A + (size_t)cur.pm * tstep; const char* cB = (const char*)g.Bt + (size_t)cur.pn * tstep;
    S.a_ready(cur);
    if constexpr (SP2) {
        PG8_STAGE(PG8_SB(0, 0), cB, voffB); PG8_STAGE(PG8_SB(0, 1), cB + hstep, voffB); PG8_STAGE(PG8_SA(0, 0), cA, voffA); PG8_STAGE(PG8_SA(0, 1), cA + hstep, voffA);
        if (wr == 1) PG8_BAR;
        PG8_WAIT_V(2); PG8_BAR;
        PG8_STAGE(PG8_SB(1, 0), cB + kstep, voffB); PG8_STAGE(PG8_SA(1, 0), cA + kstep, voffA); PG8_STAGE(PG8_SB(1, 1), cB + hstep + kstep, voffB);
        PG8_WAIT_V(6); PG8_BAR;
    } else {
        PG8_STAGE(PG8_SB(0, 0), cB, voffB); PG8_STAGE(PG8_SA(0, 0), cA, voffA); PG8_STAGE(PG8_SB(0, 1), cB + hstep, voffB); PG8_STAGE(PG8_SA(0, 1), cA + hstep, voffA);
        if (wr == 1) PG8_BAR;
        PG8_WAIT_V(4); PG8_BAR;
        PG8_STAGE(PG8_SB(1, 0), cB + kstep, voffB); PG8_STAGE(PG8_SA(1, 0), cA + kstep, voffA); PG8_STAGE(PG8_SB(1, 1), cB + hstep + kstep, voffB);
        PG8_WAIT_V(6); PG8_BAR;
    }
    for (;;) {
        const bool has_next = S.next(ui + 1, nxt);
        const char* nA = has_next ? (const char*)g.A + (size_t)nxt.pm * tstep : cA; const char* nB = has_next ? (const char*)g.Bt + (size_t)nxt.pn * tstep : cB;
        for (int t = 0; t < nt; t += 2) {
            const bool last = (t == nt - 2);
            const char* a1 = cA + (size_t)(t + 1) * kstep;
            const char* a2 = last ? nA : cA + (size_t)(t + 2) * kstep; const char* b2 = last ? nB : cB + (size_t)(t + 2) * kstep;
            const char* a3 = a2 + kstep; const char* b3 = b2 + kstep;
            if (last && has_next) S.a_ready(nxt);
            if constexpr (SP2) {
            PG8_LDB(B0, 0, 0); PG8_LDB(B1, 0, 1); PG8_SCHED; PG8_LDA(At, 0, 0); PG8_STAGE(PG8_SA(1, 1), a1 + hstep, voffA);
            PG8_WAIT_V(8); PG8_WAIT_L(0); PG8_BAR; PG8_MMA(0, 0, At, B0); PG8_MMA(0, 1, At, B1); PG8_BAR; PG8_SCHED;
            PG8_LDA(At, 0, 1); PG8_STAGE(PG8_SB(0, 0), b2, voffB); PG8_STAGE(PG8_SB(0, 1), b2 + hstep, voffB); PG8_STAGE(PG8_SA(0, 0), a2, voffA);
            PG8_WAIT_V(8); PG8_WAIT_L(0); PG8_BAR; PG8_MMA(1, 0, At, B0); PG8_MMA(1, 1, At, B1); PG8_BAR; PG8_SCHED;
            PG8_LDB(B0, 1, 0); PG8_LDB(B1, 1, 1); PG8_SCHED; PG8_LDA(At, 1, 0); PG8_STAGE(PG8_SA(0, 1), a2 + hstep, voffA);
            PG8_WAIT_V(8); PG8_WAIT_L(0); PG8_BAR; PG8_MMA(0, 0, At, B0); PG8_MMA(0, 1, At, B1); PG8_BAR; PG8_SCHED;
            PG8_LDA(At, 1, 1); PG8_STAGE(PG8_SB(1, 0), b3, voffB); PG8_STAGE(PG8_SB(1, 1), b3 + hstep, voffB); PG8_STAGE(PG8_SA(1, 0), a3, voffA);
            PG8_WAIT_V(8); PG8_WAIT_L(0); PG8_BAR; PG8_MMA(1, 0, At, B0); PG8_MMA(1, 1, At, B1); PG8_BAR; PG8_SCHED;
            } else {
            PG8_LDB(B0, 0, 0); PG8_SCHED; PG8_LDA(At, 0, 0); PG8_STAGE(PG8_SA(1, 1), a1 + hstep, voffA);
            PG8_WAIT_L(8); PG8_BAR; PG8_WAIT_L(0); PG8_MMA(0, 0, At, B0); PG8_BAR; PG8_SCHED;
            PG8_LDB(B1, 0, 1); PG8_STAGE(PG8_SB(0, 0), b2, voffB);
            PG8_BAR; PG8_WAIT_L(0); PG8_MMA(0, 1, At, B1); PG8_BAR;
            PG8_LDA(At, 0, 1); PG8_STAGE(PG8_SA(0, 0), a2, voffA);
            PG8_BAR; PG8_WAIT_L(0); PG8_MMA(1, 0, At, B0); PG8_BAR; PG8_SCHED;
            PG8_STAGE(PG8_SB(0, 1), b2 + hstep, voffB);
            PG8_WAIT_V(6); PG8_BAR; PG8_MMA(1, 1, At, B1); PG8_BAR;
            PG8_LDB(B0, 1, 0); PG8_SCHED; PG8_LDA(At, 1, 0); PG8_STAGE(PG8_SA(0, 1), a2 + hstep, voffA);
            PG8_WAIT_L(8); PG8_BAR; PG8_WAIT_L(0); PG8_MMA(0, 0, At, B0); PG8_BAR; PG8_SCHED;
            PG8_LDB(B1, 1, 1); PG8_STAGE(PG8_SB(1, 0), b3, voffB);
            PG8_BAR; PG8_WAIT_L(0); PG8_MMA(0, 1, At, B1); PG8_BAR;
            PG8_LDA(At, 1, 1); PG8_STAGE(PG8_SA(1, 0), a3, voffA);
            PG8_BAR; PG8_WAIT_L(0); PG8_MMA(1, 0, At, B0); PG8_BAR; PG8_SCHED;
            PG8_STAGE(PG8_SB(1, 1), b3 + hstep, voffB);
            PG8_WAIT_V(6); PG8_BAR; PG8_MMA(1, 1, At, B1); PG8_BAR;
            }
        }
        if constexpr (ALIGN_EPI) { if (wr == 0) PG8_BAR; }
        if constexpr (!Epi::AFTER_DRAIN) { E(acc, cur, wr, wc, fr, fq); S.done(cur); }
        if (!has_next) break;
        if (E.zero_after(cur)) {
#pragma unroll
        for (int a = 0; a < 2; ++a)
#pragma unroll
            for (int b = 0; b < 2; ++b)
#pragma unroll
                for (int m = 0; m < 4; ++m)
#pragma unroll
                    for (int n = 0; n < 2; ++n) acc[a][b][m][n] = (f32x4){zz, zz, zz, zz};
        }
        cur = nxt; cA = nA; cB = nB; ++ui;
        if constexpr (ALIGN_EPI) { if (wr == 1) PG8_BAR; }
    }
    PG8_WAIT_V(0);
    if constexpr (!ALIGN_EPI) { if (wr == 0) PG8_BAR; }
    PG8_BAR;
    if constexpr (Epi::AFTER_DRAIN) { E.fused(acc, cur, wr, wc, fr, fq, lds, wid, lane); S.done(cur); }
#undef PG8_SA
#undef PG8_SB
#undef PG8_STAGE
#undef PG8_LDA
#undef PG8_LDB
#undef PG8_MMA
#undef PG8_WAIT_V
#undef PG8_WAIT_L
#undef PG8_BAR
#undef PG8_SCHED
}
}
namespace cg = cooperative_groups;
using pg8::bf16_t; using pg8::bf16x8; using pg8::f32x4; using pg8::u32x4; using pg8::Unit;
typedef unsigned u32x2 __attribute__((ext_vector_type(2)));
#define DI __device__ __forceinline__
#define MFMA16(a, b, c) __builtin_amdgcn_mfma_f32_16x16x32_bf16((a), (b), (c), 0, 0, 0)

constexpr int MT = 16384, DM = 1024, SEQL = 2048, DFF = 2816, NPROJ = 7680, NMODW = 9216;
constexpr float EPSF = 1e-6f;
constexpr size_t OFF_CTR = 3u << 20;
constexpr size_t OFF_MOD = 0, OFF_TA = 1u << 20, OFF_TR = OFF_TA + 131072, OFF_CD = OFF_TR + 524288, OFF_DAB = 2u << 20;
constexpr size_t OFF_W = 4u << 20, OFF_U = OFF_W + 22544384, OFF_BIG = OFF_U + 83886080;
constexpr size_t OFF_H = OFF_BIG, OFF_AQKV = OFF_BIG, OFF_DQKV = OFF_AQKV + 25165824, OFF_DZ = OFF_DQKV + 50331648;
constexpr size_t OFF_R = OFF_DZ + 16777216, OFF_GATES = OFF_R + 50331648, WS_END = OFF_GATES + 100663296;
constexpr size_t OFF_WBT = OFF_W, OFF_WOT = OFF_W + 3145728, OFF_W13T = OFF_W + 5242880, OFF_W2T = OFF_W + 16777216;
constexpr size_t OFF_WINT = OFF_U + 33554432;
constexpr int LDS_BYTES = 159744;

struct Params { const float* in[21]; float* out; unsigned char* ws; int ph_lo, ph_hi; };

DI unsigned f2bf(float f) { unsigned u = __builtin_bit_cast(unsigned, f); return (u + 0x7fffu + ((u >> 16) & 1u)) >> 16; }
typedef float f32x2_t __attribute__((ext_vector_type(2))); typedef __bf16 bf16x2_t __attribute__((ext_vector_type(2)));
DI unsigned pk2(float lo, float hi) { f32x2_t v = {lo, hi}; bf16x2_t b = __builtin_convertvector(v, bf16x2_t); return __builtin_bit_cast(unsigned, b); }
#define dpp_f(x, ctrl) __builtin_bit_cast(float, __builtin_amdgcn_update_dpp(0, __builtin_bit_cast(int, (x)), (ctrl), 0xf, 0xf, false))
#define ROW_SUM16(x) do { x += dpp_f(x, 0xB1); x += dpp_f(x, 0x4E); x += dpp_f(x, 0x141); x += dpp_f(x, 0x140); } while (0)
DI float bflo(unsigned w) { return __builtin_bit_cast(float, w << 16); }
DI float bfhi(unsigned w) { return __builtin_bit_cast(float, w & 0xffff0000u); }
DI float bf1(bf16_t h) { return __builtin_bit_cast(float, (unsigned)h << 16); }
DI float silu_f(float x) { return x * __builtin_amdgcn_rcpf(1.f + __builtin_amdgcn_exp2f(-1.4426950408889634f * x)); }
DI float sigm_f(float x) { return __builtin_amdgcn_rcpf(1.f + __builtin_amdgcn_exp2f(-1.4426950408889634f * x)); }
DI bf16x8 pack8(f32x4 a, f32x4 b) { u32x4 w; w.x = pk2(a[0], a[1]); w.y = pk2(a[2], a[3]); w.z = pk2(b[0], b[1]); w.w = pk2(b[2], b[3]); return __builtin_bit_cast(bf16x8, w); }
DI bf16x8 cat8(u32x2 a, u32x2 b) { u32x4 w; w.x = a.x; w.y = a.y; w.z = b.x; w.w = b.y; return __builtin_bit_cast(bf16x8, w); }
DI void unpack8(u32x4 w, float* f) { f[0] = bflo(w.x); f[1] = bfhi(w.x); f[2] = bflo(w.y); f[3] = bfhi(w.y); f[4] = bflo(w.z); f[5] = bfhi(w.z); f[6] = bflo(w.w); f[7] = bfhi(w.w); }

struct EpiSwiGLU { static constexpr bool PERM = true, AFTER_DRAIN = false; bf16_t* H;
    DI bool zero_after(const Unit&) const { return true; }
    DI void operator()(const f32x4 (&acc)[2][2][4][2], const Unit& u, int wr, int wc, int fr, int fq) const {
        const int row0 = u.pm * 256 + wr * 64 + fr, col0 = u.pn * 128 + wc * 32 + 8 * fq;
#pragma unroll
        for (int ai = 0; ai < 2; ++ai)
#pragma unroll
            for (int m = 0; m < 4; ++m) { bf16_t* p = H + (size_t)(row0 + ai * 128 + m * 16) * DFF + col0;
                const f32x4 g0 = acc[ai][0][m][0], g1 = acc[ai][0][m][1], u0 = acc[ai][1][m][0], u1 = acc[ai][1][m][1];
                u32x4 w; w.x = pk2(silu_f(g0[0]) * u0[0], silu_f(g0[1]) * u0[1]); w.y = pk2(silu_f(g0[2]) * u0[2], silu_f(g0[3]) * u0[3]);
                w.z = pk2(silu_f(g1[0]) * u1[0], silu_f(g1[1]) * u1[1]); w.w = pk2(silu_f(g1[2]) * u1[2], silu_f(g1[3]) * u1[3]);
                *(u32x4*)p = w; }
    } };
struct EpiResid { static constexpr bool PERM = true, AFTER_DRAIN = false; const float* src; float* dst; const float* modv; float gs;
    DI bool zero_after(const Unit&) const { return true; }
    DI void operator()(const f32x4 (&acc)[2][2][4][2], const Unit& u, int wr, int wc, int fr, int fq) const {
        asm volatile("" : "+v"(fr), "+v"(fq));
        const int row0 = u.pm * 256 + wr * 64 + fr; const float* mb = modv + (size_t)(u.pm >> 3) * NMODW;
        const int colb = u.pn * 256 + wc * 32 + 8 * fq;
        f32x4 mv[2][2];
#pragma unroll
        for (int bj = 0; bj < 2; ++bj)
#pragma unroll
            for (int n = 0; n < 2; ++n) mv[bj][n] = *(const f32x4*)(mb + colb + bj * 128 + 4 * n) * gs;
#pragma unroll
        for (int ai = 0; ai < 2; ++ai)
#pragma unroll
            for (int m = 0; m < 4; ++m) { const size_t o = (size_t)(row0 + ai * 128 + m * 16) * DM + colb;
                const f32x4 s00 = *(const f32x4*)(src + o), s01 = *(const f32x4*)(src + o + 4), s10 = *(const f32x4*)(src + o + 128), s11 = *(const f32x4*)(src + o + 132);
                *(f32x4*)(dst + o) = s00 + mv[0][0] * acc[ai][0][m][0]; *(f32x4*)(dst + o + 4) = s01 + mv[0][1] * acc[ai][0][m][1];
                *(f32x4*)(dst + o + 128) = s10 + mv[1][0] * acc[ai][1][m][0]; *(f32x4*)(dst + o + 132) = s11 + mv[1][1] * acc[ai][1][m][1]; }
    } };
struct EpiProj { static constexpr bool PERM = true, AFTER_DRAIN = false; unsigned char* ws;
    DI bool zero_after(const Unit&) const { return true; }
    DI void operator()(const f32x4 (&acc)[2][2][4][2], const Unit& u, int wr, int wc, int fr, int fq) const {
        asm volatile("" : "+v"(fr), "+v"(fq));
        const int pn = u.pn, row0 = u.pm * 256 + wr * 64 + fr;
        if (pn == 29) { float* dab = (float*)(ws + OFF_DAB);
            if (wc == 0 && fq < 2) {
#pragma unroll
                for (int ai = 0; ai < 2; ++ai)
#pragma unroll
                    for (int m = 0; m < 4; ++m)
#pragma unroll
                        for (int n = 0; n < 2; ++n) *(f32x4*)(dab + (size_t)(row0 + ai * 128 + m * 16) * 16 + 8 * fq + 4 * n) = acc[ai][0][m][n]; }
            return; }
        bf16_t* base; int ld, c0, act = 0;
        if (pn < 3) { base = (bf16_t*)(ws + OFF_AQKV); ld = 768; c0 = pn * 256; }
        else if (pn < 9) { base = (bf16_t*)(ws + OFF_DQKV); ld = 1536; c0 = (pn - 3) * 256; }
        else if (pn < 11) { base = (bf16_t*)(ws + OFF_DZ); ld = 512; c0 = (pn - 9) * 256; act = 1; }
        else if (pn < 17) { base = (bf16_t*)(ws + OFF_R); ld = 1536; c0 = (pn - 11) * 256; act = (pn >= 15) ? 1 : 0; }
        else { base = (bf16_t*)(ws + OFF_GATES); ld = 3072; c0 = (pn - 17) * 256; act = 2; }
        const int col0 = c0 + wc * 32 + 8 * fq;
#pragma unroll
        for (int ai = 0; ai < 2; ++ai)
#pragma unroll
            for (int m = 0; m < 4; ++m) { bf16_t* rowp = base + (size_t)(row0 + ai * 128 + m * 16) * ld + col0;
#pragma unroll
                for (int bj = 0; bj < 2; ++bj) { f32x4 v0 = acc[ai][bj][m][0], v1 = acc[ai][bj][m][1];
                    if (pn == 11 || pn == 12) {
                        const int row = row0 + ai * 128 + m * 16, cit = bj * 128 + wc * 32 + 8 * fq, hh = cit >> 6, d0 = cit & 63, pos = row & (SEQL - 1), ii = row & 63;
                        const float* tr = (const float*)(ws + OFF_TR) + ((size_t)pos * 32 + (d0 >> 1)) * 2; const f32x4 t0 = *(const f32x4*)tr, t1 = *(const f32x4*)(tr + 4);
                        const float lgh = logf(1.f - exp2f(-5.f - (float)hh)), sc = (pn == 11) ? expf(lgh * (float)(ii + 1)) : 0.125f * expf(lgh * (float)(63 - ii));
                        const f32x4 a = v0, bq = v1;
                        v0[0] = (a[0] * t0[0] - a[1] * t0[1]) * sc; v0[1] = (a[1] * t0[0] + a[0] * t0[1]) * sc; v0[2] = (a[2] * t0[2] - a[3] * t0[3]) * sc; v0[3] = (a[3] * t0[2] + a[2] * t0[3]) * sc;
                        v1[0] = (bq[0] * t1[0] - bq[1] * t1[1]) * sc; v1[1] = (bq[1] * t1[0] + bq[0] * t1[1]) * sc; v1[2] = (bq[2] * t1[2] - bq[3] * t1[3]) * sc; v1[3] = (bq[3] * t1[2] + bq[2] * t1[3]) * sc; }
                    if (act == 1) { for (int e = 0; e < 4; ++e) { v0[e] = silu_f(v0[e]); v1[e] = silu_f(v1[e]); } }
                    else if (act == 2) { for (int e = 0; e < 4; ++e) { v0[e] = sigm_f(v0[e]); v1[e] = sigm_f(v1[e]); } }
                    *(u32x4*)(rowp + bj * 128) = __builtin_bit_cast(u32x4, pack8(v0, v1)); } }
    } };
struct EpiMerge { static constexpr bool PERM = true, AFTER_DRAIN = false; const bf16_t* gates; bf16_t* merged;
    DI bool zero_after(const Unit& u) const { return (u.pn >> 2) == 2; }
    DI void operator()(f32x4 (&acc)[2][2][4][2], const Unit& u, int wr, int wc, int fr, int fq) const {
        asm volatile("" : "+v"(fr), "+v"(fq));
        const int b = u.pn >> 2, pm = u.pm & 63, pn = u.pn & 3, row0 = pm * 256 + wr * 64 + fr;
#pragma unroll
        for (int ai = 0; ai < 2; ++ai)
#pragma unroll
            for (int bj = 0; bj < 2; ++bj) { const int col0 = pn * 256 + bj * 128 + wc * 32 + 8 * fq;
                u32x4 gr[4], gnr[4];
#pragma unroll
                for (int m = 0; m < 4; ++m) { const size_t row = (size_t)(row0 + ai * 128 + m * 16); gr[m] = *(const u32x4*)(gates + row * 3072 + b * 1024 + col0);
                    gnr[m] = (b < 2) ? *(const u32x4*)(gates + row * 3072 + (b + 1) * 1024 + col0) : gr[m]; }
#pragma unroll
                for (int m = 0; m < 4; ++m) { const size_t row = (size_t)(row0 + ai * 128 + m * 16);
                    float g[8]; unpack8(gr[m], g);
                    f32x4& v0 = acc[ai][bj][m][0]; f32x4& v1 = acc[ai][bj][m][1];
                    if (b < 2) { float gn[8]; unpack8(gnr[m], gn);
#pragma unroll
                        for (int e = 0; e < 4; ++e) { v0[e] *= fmaxf(g[e], 1e-20f) * __builtin_amdgcn_rcpf(fmaxf(gn[e], 1e-20f)); v1[e] *= fmaxf(g[4 + e], 1e-20f) * __builtin_amdgcn_rcpf(fmaxf(gn[4 + e], 1e-20f)); } }
                    else { u32x4 w; w.x = pk2(v0[0] * fmaxf(g[0], 1e-20f), v0[1] * fmaxf(g[1], 1e-20f)); w.y = pk2(v0[2] * fmaxf(g[2], 1e-20f), v0[3] * fmaxf(g[3], 1e-20f));
                        w.z = pk2(v1[0] * fmaxf(g[4], 1e-20f), v1[1] * fmaxf(g[5], 1e-20f)); w.w = pk2(v1[2] * fmaxf(g[6], 1e-20f), v1[3] * fmaxf(g[7], 1e-20f));
                        *(u32x4*)(merged + row * DM + col0) = w; } } }
    } };
struct MergeOrder { int G, c;
    DI bool next(int i, Unit& u) const { const int T = c + G * (i / 3), b = i % 3; if (T >= 256) return false; u.pm = b * 64 + (T >> 2); u.pn = b * 4 + (T & 3); return true; }
    DI void a_ready(const Unit&) const {} DI void done(const Unit&) const {} };

DI float wave_sum(float v) {
#pragma unroll
    for (int o = 1; o < 64; o <<= 1) v += __shfl_xor(v, o);
    return v; }

DI void phase_mod(const Params& p, unsigned char* lds, int tid) {
    float* sc = (float*)lds; float* red = sc + 8192;
    const float* c = p.in[1]; float* MOD = (float*)(p.ws + OFF_MOD);
    for (int i = tid; i < 8192; i += 512) { const float v = c[i]; sc[i] = v / (1.f + expf(-v)); }
    __syncthreads();
    for (int grp = blockIdx.x; grp < 256; grp += gridDim.x) {
        const int cc = tid % 72, kp = tid / 72;
        const int n = grp * 72 + cc, l = n / NMODW, nn = n % NMODW;
        float a0 = 0, a1 = 0, a2 = 0, a3 = 0, a4 = 0, a5 = 0, a6 = 0, a7 = 0;
        if (kp < 7) {
            const float* w = p.in[2] + (size_t)l * DM * NMODW + nn;
            for (int kb = kp * 147; kb < kp * 147 + 147; kb += 21) {
                float wv[21];
#pragma unroll
                for (int q = 0; q < 21; ++q) { const int k = kb + q; wv[q] = (k < DM) ? w[(size_t)k * NMODW] : 0.f; }
#pragma unroll
                for (int q = 0; q < 21; ++q) { const int k = (kb + q < DM) ? kb + q : 0; const float x = wv[q];
                    a0 += sc[k] * x; a1 += sc[1024 + k] * x; a2 += sc[2048 + k] * x; a3 += sc[3072 + k] * x; a4 += sc[4096 + k] * x; a5 += sc[5120 + k] * x; a6 += sc[6144 + k] * x; a7 += sc[7168 + k] * x; }
            }
            red[(kp * 8 + 0) * 72 + cc] = a0; red[(kp * 8 + 1) * 72 + cc] = a1; red[(kp * 8 + 2) * 72 + cc] = a2; red[(kp * 8 + 3) * 72 + cc] = a3;
            red[(kp * 8 + 4) * 72 + cc] = a4; red[(kp * 8 + 5) * 72 + cc] = a5; red[(kp * 8 + 6) * 72 + cc] = a6; red[(kp * 8 + 7) * 72 + cc] = a7;
        }
        __syncthreads();
        for (int o = tid; o < 8 * 72; o += 512) { const int b = o / 72, c2 = o % 72; float s = 0.f;
#pragma unroll
            for (int q = 0; q < 7; ++q) s += red[(q * 8 + b) * 72 + c2];
            const int n2 = grp * 72 + c2, l2 = n2 / NMODW, nn2 = n2 % NMODW;
            MOD[(size_t)(l2 * 8 + b) * NMODW + nn2] = s + p.in[3][l2 * NMODW + nn2]; }
        __syncthreads();
    }
    const int gt = blockIdx.x * 512 + tid, NT = gridDim.x * 512;
    float* TA = (float*)(p.ws + OFF_TA); float* TR = (float*)(p.ws + OFF_TR);
    for (int idx = gt; idx < 2048 * 8; idx += NT) { const int pos = idx >> 3, pp = idx & 7;
        const float invf = exp2f(-18.931568569324174f * ((float)(2 * pp) * (1.f / 16.f))); float rev = (float)pos * invf * 0.15915494309189535f; rev -= rintf(rev);
        TA[idx * 2] = __builtin_amdgcn_cosf(rev); TA[idx * 2 + 1] = __builtin_amdgcn_sinf(rev); }
    for (int idx = gt; idx < 2048 * 32; idx += NT) { const int pos = idx >> 5, pp = idx & 31;
        const float ang = exp2f(-13.287712379549449f * ((float)pp * (1.f / 31.f))); float rev = (float)pos * ang * 0.15915494309189535f; rev -= rintf(rev);
        TR[idx * 2] = __builtin_amdgcn_cosf(rev); TR[idx * 2 + 1] = __builtin_amdgcn_sinf(rev); }
}

DI int dstrow(int mode, int n) {
    if (mode == 1) return (n < DFF) ? ((n >> 7) * 256 + (n & 127)) : (((n - DFF) >> 7) * 256 + 128 + ((n - DFF) & 127));
    if (mode == 2) return (n < 2304) ? n : ((n < 2320) ? (7424 + n - 2304) : (n - 16));
    return n; }
DI void conv_item(const float* W, int K, int N, bf16_t* WT, int mode, float* scr, int item, int lane) {
    const int nblk = (N + 31) / 32, kb = item / nblk, nb = item % nblk, k0 = 64 * kb, n0 = 32 * nb;
    const int nn = n0 + (lane & 31); const bool okn = nn < N;
    float wv[32];
#pragma unroll
    for (int i = 0; i < 32; ++i) { const int kk = 2 * i + (lane >> 5); wv[i] = okn ? W[(size_t)(k0 + kk) * N + nn] : 0.f; }
#pragma unroll
    for (int i = 0; i < 32; ++i) { const int kk = 2 * i + (lane >> 5); scr[kk * 33 + (lane & 31)] = wv[i]; }
    asm volatile("s_waitcnt lgkmcnt(0)" ::: "memory");
    const int c = lane & 7;
#pragma unroll
    for (int j = 0; j < 4; ++j) { const int n = (lane >> 3) + 8 * j; const float* s = scr + (8 * c) * 33 + n;
        u32x4 o; o.x = pk2(s[0 * 33], s[1 * 33]); o.y = pk2(s[2 * 33], s[3 * 33]); o.z = pk2(s[4 * 33], s[5 * 33]); o.w = pk2(s[6 * 33], s[7 * 33]);
        if (n0 + n < N) *(u32x4*)(WT + (size_t)dstrow(mode, n0 + n) * K + k0 + 8 * c) = o; }
    asm volatile("s_waitcnt lgkmcnt(0)" ::: "memory");
}
DI void mod_issue(const float* x, int gw, int NGW, int lane, int m0, int (&mr)[4], f32x4 (&v)[4][4]) {
#pragma unroll
    for (int q = 0; q < 4; ++q) { mr[q] = (m0 + q * NGW < MT) ? m0 + q * NGW : m0;
#pragma unroll
        for (int j = 0; j < 4; ++j) v[q][j] = ((const f32x4*)(x + (size_t)mr[q] * DM) + lane)[64 * j]; }
}
DI void mod_finish(const float* gain, const float* modl, int slot, bf16_t* U, int lane, const int (&mr)[4], const f32x4 (&v)[4][4]) {
    float s[4];
#pragma unroll
    for (int q = 0; q < 4; ++q) { float a = 0.f;
#pragma unroll
        for (int j = 0; j < 4; ++j) a += (v[q][j][0] * v[q][j][0] + v[q][j][1] * v[q][j][1]) + (v[q][j][2] * v[q][j][2] + v[q][j][3] * v[q][j][3]);
        s[q] = rsqrtf(wave_sum(a) * (1.f / DM) + EPSF); }
#pragma unroll
    for (int j = 0; j < 4; ++j) { const int d = 4 * lane + 256 * j; const f32x4 g = *(const f32x4*)(gain + d);
#pragma unroll
        for (int q = 0; q < 4; ++q) { const float* mb = modl + (size_t)(mr[q] >> 11) * NMODW + slot * 3 * DM;
            const f32x4 y = v[q][j] * s[q] * g * (*(const f32x4*)(mb + DM + d) + 1.f) + *(const f32x4*)(mb + d);
            ((unsigned long long*)(U + (size_t)mr[q] * DM) + lane)[64 * j] = (unsigned long long)pk2(y[0], y[1]) | ((unsigned long long)pk2(y[2], y[3]) << 32); } }
}
DI void convert_ffn(const Params& p, int l, int which  , unsigned char* lds, int tid, int gw, int NGW) {
    const int lane = tid & 63, wave = tid >> 6; float* scr = (float*)(lds + wave * 16384);
    const float* w13 = p.in[which == 0 ? 5 : 19] + (size_t)l * DM * 2 * DFF; const float* w2 = p.in[which == 0 ? 6 : 20] + (size_t)l * DFF * DM;
    constexpr int I13 = 16 * 176, I2 = 44 * 32;
    for (int it = gw; it < I13 + I2; it += NGW) {
        if (it < I13) conv_item(w13, DM, 2 * DFF, (bf16_t*)(p.ws + OFF_W13T), 1, scr, it, lane);
        else conv_item(w2, DFF, DM, (bf16_t*)(p.ws + OFF_W2T), 0, scr, it - I13, lane); }
}
DI void convert_mix(const Params& p, int l, unsigned char* lds, int tid, int gw, int NGW) {
    unsigned zu = 0u; asm volatile("" : "+v"(zu));
    const int lane = tid & 63, wave = tid >> 6; float* scr = (float*)(lds + wave * 16384);
    const float* win = p.in[8] + (size_t)l * DM * 7440; const float* wb = p.in[16] + (size_t)l * 3 * 512 * DM; const float* wo = p.in[17] + (size_t)l * DM * DM;
    constexpr int IIN = 16 * 233, IB = 8 * 32, IO = 16 * 32;
    for (int it = gw; it < IIN + 3 * IB + IO; it += NGW) { int r = it;
        if (r < IIN) { conv_item(win, DM, 7440, (bf16_t*)(p.ws + OFF_WINT), 2, scr, r, lane); continue; } r -= IIN;
        if (r < 3 * IB) { const int g = r / IB; conv_item(wb + (size_t)g * 512 * DM, 512, DM, (bf16_t*)(p.ws + OFF_WBT) + (size_t)g * DM * 512, 0, scr, r % IB, lane); continue; } r -= 3 * IB;
        conv_item(wo, DM, DM, (bf16_t*)(p.ws + OFF_WOT), 0, scr, r, lane); }
    u32x4* z = (u32x4*)(p.ws + OFF_WINT + (size_t)7440 * DM * 2);
    for (int i = gw * 64 + lane; i < 240 * DM * 2 / 16; i += NGW * 64) z[i] = (u32x4){zu, zu, zu, zu};
}
DI void phase_prep(const Params& p, int l, int which  , const float* xsrc, unsigned char* lds, int tid) {
    const int lane = tid & 63, wave = tid >> 6, gw = blockIdx.x * 8 + wave, NGW = gridDim.x * 8;
    const float* gain = p.in[which == 0 ? 4 : (which == 1 ? 7 : 18)] + l * DM; const float* modl = (const float*)(p.ws + OFF_MOD) + (size_t)l * 8 * NMODW; bf16_t* U = (bf16_t*)(p.ws + OFF_U);
    int mrA[4]; f32x4 vA[4][4];
    mod_issue(xsrc, gw, NGW, lane, gw, mrA, vA);
    if (which == 1) convert_mix(p, l, lds, tid, gw, NGW); else convert_ffn(p, l, which, lds, tid, gw, NGW);
    for (int m0 = gw; m0 < MT; m0 += 8 * NGW) {
        int mrB[4]; f32x4 vB[4][4]; const bool hb = m0 + 4 * NGW < MT;
        if (hb) mod_issue(xsrc, gw, NGW, lane, m0 + 4 * NGW, mrB, vB);
        mod_finish(gain, modl, which, U, lane, mrA, vA);
        if (m0 + 8 * NGW < MT) mod_issue(xsrc, gw, NGW, lane, m0 + 8 * NGW, mrA, vA);
        if (hb) mod_finish(gain, modl, which, U, lane, mrB, vB);
    }
}
constexpr int PREP_CHUNK_BYTES = 40960;
DI void dn_prep_fetch(const Params& p, int item, int tid, u32x4 (&pre)[12]) {
    const int h = item & 7, n = (item >> 3) & 31, b = item >> 8, i = tid >> 3, d0 = (tid & 7) * 8;
    const bf16_t* DQKV = (const bf16_t*)(p.ws + OFF_DQKV);
#pragma unroll
    for (int mat = 0; mat < 3; ++mat)
#pragma unroll
        for (int j = 0; j < 4; ++j) { int t = n * 64 + i - 3 + j; t = t < 0 ? 0 : t; pre[mat * 4 + j] = *(const u32x4*)(DQKV + (size_t)(b * SEQL + t) * 1536 + mat * 512 + h * 64 + d0); }
}
DI void dn_prep_item(const Params& p, int l, int item, int next_item, u32x4 (&pre)[12], unsigned char* lds, int tid) {
    float zz = 0.f; asm volatile("" : "+v"(zz));
    const int h = item & 7, n = (item >> 3) & 31, b = item >> 8, lane = tid & 63;
    float* Qs = (float*)lds; float* Ks = Qs + 4160; float* Vs = Ks + 4160; float* Ls = Vs + 4160; float* AIs = Ls + 4096; float* XS = AIs + 4096;
    float* Gs = XS + 64 * 129; float* BETAs = Gs + 64; float* EGs = BETAs + 64;
    bf16_t* KH = (bf16_t*)(EGs + 64); bf16_t* KL = KH + 64 * 72; bf16_t* QH = KL + 64 * 72; bf16_t* QL = QH + 64 * 72;
    const float* DAB = (const float*)(p.ws + OFF_DAB);
    const float* cw = p.in[12] + (size_t)l * 4 * 1536;
    float da_raw = 0.f, db_raw = 0.f, dtb = 0.f, alog = 0.f;
    if (tid < 64) { const size_t tok = (size_t)b * SEQL + n * 64 + tid; da_raw = DAB[tok * 16 + h]; db_raw = DAB[tok * 16 + 8 + h]; dtb = p.in[14][l * 8 + h]; alog = p.in[13][l * 8 + h]; }
    {
        const int i = tid >> 3, d0 = (tid & 7) * 8;
#pragma unroll
        for (int mat = 0; mat < 3; ++mat) { const int col = mat * 512 + h * 64 + d0; float a[8];
#pragma unroll
            for (int e = 0; e < 8; ++e) a[e] = 0.f;
#pragma unroll
            for (int j = 0; j < 4; ++j) { const int t = n * 64 + i - 3 + j;
                if (t >= 0) { float xv[8]; unpack8(pre[mat * 4 + j], xv);
                    const f32x4 w0 = *(const f32x4*)(cw + j * 1536 + col), w1 = *(const f32x4*)(cw + j * 1536 + col + 4);
#pragma unroll
                    for (int e = 0; e < 4; ++e) { a[e] += w0[e] * xv[e]; a[4 + e] += w1[e] * xv[4 + e]; } } }
            float ss = 0.f;
#pragma unroll
            for (int e = 0; e < 8; ++e) { a[e] = silu_f(a[e]); ss += a[e] * a[e]; }
            float sc = 1.f;
            if (mat < 2) { ss += __shfl_xor(ss, 1); ss += __shfl_xor(ss, 2); ss += __shfl_xor(ss, 4); sc = rsqrtf(ss + EPSF) * (mat == 0 ? 0.125f : 1.f); }
            float* dst = (mat == 0 ? Qs : (mat == 1 ? Ks : Vs)) + i * 65 + d0;
#pragma unroll
            for (int e = 0; e < 8; ++e) { a[e] *= sc; dst[e] = a[e]; }
            if (mat < 2) { float hf[8], lo[8]; u32x4 wh, wl;
                wh.x = pk2(a[0], a[1]); wh.y = pk2(a[2], a[3]); wh.z = pk2(a[4], a[5]); wh.w = pk2(a[6], a[7]); unpack8(wh, hf);
#pragma unroll
                for (int e = 0; e < 8; ++e) lo[e] = a[e] - hf[e];
                wl.x = pk2(lo[0], lo[1]); wl.y = pk2(lo[2], lo[3]); wl.z = pk2(lo[4], lo[5]); wl.w = pk2(lo[6], lo[7]);
                *(u32x4*)((mat == 0 ? QH : KH) + i * 72 + d0) = wh; *(u32x4*)((mat == 0 ? QL : KL) + i * 72 + d0) = wl; } }
        { f32x4* z = (f32x4*)AIs + tid * 2; z[0] = (f32x4){zz, zz, zz, zz}; z[1] = (f32x4){zz, zz, zz, zz}; }
    }
    if (tid < 64) {
        const float a = da_raw + dtb, bb = db_raw;
        const float sp = (a > 20.f) ? a : ((a < -15.f) ? expf(a) : logf(1.f + expf(a)));
        float x = -expf(alog) * sp;
#pragma unroll
        for (int o = 1; o < 64; o <<= 1) { const float v = __shfl_up(x, o); if (lane >= o) x += v; }
        Gs[tid] = x; BETAs[tid] = 1.f / (1.f + expf(-bb)); EGs[tid] = expf(x);
    }
    __syncthreads();
    {
        const int wv = tid >> 6, c = lane & 15, g = lane >> 4;
        for (int t = wv; t < 20; t += 8) { const int isq = t >= 10, tt = isq ? t - 10 : t, it = (tt >= 6) ? 3 : ((tt >= 3) ? 2 : ((tt >= 1) ? 1 : 0)), jt = tt - it * (it + 1) / 2;
            const bf16_t* XHp = (isq ? QH : KH) + (16 * it + c) * 72 + 8 * g; const bf16_t* XLp = (isq ? QL : KL) + (16 * it + c) * 72 + 8 * g;
            const bf16_t* KHp = KH + (16 * jt + c) * 72 + 8 * g; const bf16_t* KLp = KL + (16 * jt + c) * 72 + 8 * g;
            f32x4 acc = (f32x4){zz, zz, zz, zz};
#pragma unroll
            for (int s = 0; s < 2; ++s) { const bf16x8 xh = *(const bf16x8*)(XHp + 32 * s), xl = *(const bf16x8*)(XLp + 32 * s), kh = *(const bf16x8*)(KHp + 32 * s), kl = *(const bf16x8*)(KLp + 32 * s);
                acc = MFMA16(xl, kh, acc); acc = MFMA16(xh, kl, acc); acc = MFMA16(xh, kh, acc); }
            const int jj = 16 * jt + c; const float gj = Gs[jj];
#pragma unroll
            for (int rr = 0; rr < 4; ++rr) { const int ii = 16 * it + 4 * g + rr; const float dec = (jj <= ii) ? expf(Gs[ii] - gj) : 0.f;
                if (isq) AIs[ii * 64 + jj] = (jj <= ii) ? acc[rr] * dec : 0.f; else Ls[ii * 64 + jj] = (jj < ii) ? BETAs[ii] * acc[rr] * dec : 0.f; } }
    }
    __syncthreads();
    {
        const int wv = tid >> 6; float* Zs = (float*)(QL + 64 * 72);
        if (wv < 5) {
            const int half = (wv >= 2) ? 1 : 0, c = (wv < 2) ? tid : ((wv < 4) ? tid - 128 : (lane & 31)), r0 = 32 * half;
            const float* Lb = Ls + r0 * 64 + r0;
            float x[32];
            if (wv < 4) {
#pragma unroll
                for (int i = 0; i < 32; ++i) x[i] = (c < 64) ? BETAs[r0 + i] * Vs[(r0 + i) * 65 + c] : BETAs[r0 + i] * Ks[(r0 + i) * 65 + c - 64] * EGs[r0 + i];
            } else {
#pragma unroll
                for (int i = 0; i < 32; ++i) x[i] = Ls[(32 + i) * 64 + c];
            }
            f32x4 cur[8], nxt[8];
            cur[0] = *(const f32x4*)(Lb + 64);
#pragma unroll
            for (int i = 1; i < 32; ++i) {
                if (i < 31) {
#pragma unroll
                    for (int q = 0; q < 8; ++q) if (4 * q < i + 1) nxt[q] = *(const f32x4*)(Lb + (i + 1) * 64 + 4 * q);
                }
                float a0 = x[i], a1 = 0.f, a2 = 0.f, a3 = 0.f;
#pragma unroll
                for (int j = 0; j < i; ++j) { const float lv = cur[j >> 2][j & 3];
                    if ((j & 3) == 0) a0 -= lv * x[j]; else if ((j & 3) == 1) a1 -= lv * x[j]; else if ((j & 3) == 2) a2 -= lv * x[j]; else a3 -= lv * x[j]; }
                x[i] = (a0 + a1) + (a2 + a3);
#pragma unroll
                for (int q = 0; q < 8; ++q) cur[q] = nxt[q];
            }
            if (wv < 4) {
#pragma unroll
                for (int i = 0; i < 32; ++i) XS[(r0 + i) * 129 + c] = x[i];
            } else if (lane < 32) {
#pragma unroll
                for (int i = 0; i < 32; ++i) Zs[i * 33 + c] = x[i];
            }
        } else {
            const int chunk_ = (b * 8 + h) * 32 + n; unsigned char* base_ = p.ws + OFF_U + (size_t)chunk_ * PREP_CHUNK_BYTES;
            const int r = lane & 15, g = lane >> 4; const float g63 = Gs[63];
            for (int q = wv - 5; q < 24; q += 3) { const int mat = q >> 3, f = q & 7, m = f >> 1, s = f & 1, row = 16 * m + r, c0 = 32 * s + 4 * g, c1 = c0 + 16;
                float v[8];
                if (mat == 0) { const float eg = EGs[row]; const float* a = Qs + row * 65;
#pragma unroll
                    for (int e = 0; e < 4; ++e) { v[e] = a[c0 + e] * eg; v[4 + e] = a[c1 + e] * eg; } }
                else if (mat == 1) { const float* a = AIs + row * 64;
#pragma unroll
                    for (int e = 0; e < 4; ++e) { v[e] = a[c0 + e]; v[4 + e] = a[c1 + e]; } }
                else {
#pragma unroll
                    for (int e = 0; e < 4; ++e) { v[e] = Ks[(c0 + e) * 65 + row] * expf(g63 - Gs[c0 + e]); v[4 + e] = Ks[(c1 + e) * 65 + row] * expf(g63 - Gs[c1 + e]); } }
                u32x4 w; w.x = pk2(v[0], v[1]); w.y = pk2(v[2], v[3]); w.z = pk2(v[4], v[5]); w.w = pk2(v[6], v[7]);
                *(u32x4*)(base_ + 8192 * (mat + 1) + (size_t)(f * 64 + lane) * 16) = w; }
        }
        __syncthreads();
        {
            const int c = tid & 127, rg = tid >> 7;
            float xt[32];
#pragma unroll
            for (int k = 0; k < 32; ++k) xt[k] = XS[k * 129 + c];
#pragma unroll
            for (int ii = 0; ii < 8; ++ii) { const int i = rg * 8 + ii; float a0 = XS[(32 + i) * 129 + c], a1 = 0.f;
#pragma unroll
                for (int k = 0; k < 32; k += 2) { a0 -= Zs[i * 33 + k] * xt[k]; a1 -= Zs[i * 33 + k + 1] * xt[k + 1]; }
                XS[(32 + i) * 129 + c] = a0 + a1; }
        }
    }
    __syncthreads();
    dn_prep_fetch(p, next_item < 2048 ? next_item : item, tid, pre);
    {
        const int chunk = (b * 8 + h) * 32 + n; unsigned char* base = p.ws + OFF_U + (size_t)chunk * PREP_CHUNK_BYTES;
        const int f = tid >> 6, m = f >> 1, s = f & 1, r = lane & 15, g = lane >> 4, row = 16 * m + r, c0 = 32 * s + 4 * g, c1 = c0 + 16;
        u32x4 w;
        { const float* a = XS + row * 129 + 64; w.x = pk2(a[c0], a[c0 + 1]); w.y = pk2(a[c0 + 2], a[c0 + 3]); w.z = pk2(a[c1], a[c1 + 1]); w.w = pk2(a[c1 + 2], a[c1 + 3]); *(u32x4*)(base + (size_t)tid * 16) = w; }
#pragma unroll
        for (int q = 0; q < 2; ++q) { const int idx = tid * 2 + q, wm = idx >> 6, ln = idx & 63, vv = 16 * (wm >> 2) + (ln & 15), r0 = 16 * (wm & 3) + 4 * (ln >> 4);
            u32x2 o; o.x = pk2(XS[r0 * 129 + vv], XS[(r0 + 1) * 129 + vv]); o.y = pk2(XS[(r0 + 2) * 129 + vv], XS[(r0 + 3) * 129 + vv]); *(u32x2*)(base + 32768 + (size_t)idx * 8) = o; }
        if (tid == 0) ((float*)(p.ws + OFF_CD))[chunk] = EGs[63];
    }
    __syncthreads();
}

DI void dn_scan_wg(const Params& p, int l, int bh, unsigned char* lds, int tid) {
    float zz = 0.f; unsigned zu = 0u; asm volatile("" : "+v"(zz), "+v"(zu));
    const int lane = tid & 63, w = tid >> 6, b = bh >> 3, h = bh & 7, c = lane & 15, g = lane >> 4;
    unsigned char* OX = lds + 2 * PREP_CHUNK_BYTES;
    const bf16_t* DZ = (const bf16_t*)(p.ws + OFF_DZ); bf16_t* BRB = (bf16_t*)(p.ws + OFF_DQKV) + (size_t)MT * 512;
    const unsigned char* gsrc = p.ws + OFF_U + (size_t)(bh * 32) * PREP_CHUNK_BYTES;
    const float* CDp = (const float*)(p.ws + OFF_CD) + bh * 32;
    {
        u32x4 t0[5];
#pragma unroll
        for (int k = 0; k < 5; ++k) t0[k] = *(const u32x4*)(gsrc + (size_t)tid * 16 + k * 8192);
#pragma unroll
        for (int k = 0; k < 5; ++k) *(u32x4*)(lds + tid * 16 + k * 8192) = t0[k];
    }
    const int st = (w & 3) * 64 + lane;
    u32x4 stA[10], stB[10]; bf16_t gzA[4][4], gzB[4][4]; float onv[4];
    f32x4 S[4];
#pragma unroll
    for (int i = 0; i < 4; ++i) S[i] = (f32x4){zz, zz, zz, zz};
    if (w >= 4) {
#pragma unroll
        for (int k = 0; k < 10; ++k) { stA[k] = *(const u32x4*)(gsrc + (size_t)PREP_CHUNK_BYTES + (size_t)st * 16 + k * 4096); stB[k] = stA[k]; }
#pragma unroll
        for (int q = 0; q < 4; ++q) onv[q] = p.in[15][l * 64 + 16 * q + c];
#pragma unroll
        for (int q = 0; q < 4; ++q)
#pragma unroll
            for (int r = 0; r < 4; ++r) { gzA[q][r] = 0; gzB[q][r] = 0; }
    }
    __syncthreads();
#define DN_FINAL(nn, GZ) do { const unsigned char* ox = OX + ((nn) & 1) * 16384; const int x = w - 4; f32x4 o[4]; float q0 = 0.f, q1 = 0.f, q2 = 0.f, q3 = 0.f; \
        _Pragma("unroll") for (int q = 0; q < 4; ++q) { o[q] = *(const f32x4*)(ox + ((q * 4 + x) * 64 + lane) * 16); q0 += o[q][0] * o[q][0]; q1 += o[q][1] * o[q][1]; q2 += o[q][2] * o[q][2]; q3 += o[q][3] * o[q][3]; } \
        ROW_SUM16(q0); ROW_SUM16(q1); ROW_SUM16(q2); ROW_SUM16(q3); \
        const float rs[4] = {rsqrtf(q0 * (1.f / 64.f) + EPSF), rsqrtf(q1 * (1.f / 64.f) + EPSF), rsqrtf(q2 * (1.f / 64.f) + EPSF), rsqrtf(q3 * (1.f / 64.f) + EPSF)}; \
        _Pragma("unroll") for (int q = 0; q < 4; ++q) _Pragma("unroll") for (int r = 0; r < 4; ++r) { \
            const size_t tok = (size_t)b * SEQL + (nn) * 64 + 16 * x + 4 * g + r; \
            BRB[tok * 512 + h * 64 + 16 * q + c] = (bf16_t)f2bf(o[q][r] * rs[r] * onv[q] * bf1(GZ[q][r])); } } while (0)
#define DN_STEP(n, X, Y, GZC, GZN) do { \
        if (w < 4) { \
            const unsigned char* buf = lds + ((n) & 1) * PREP_CHUNK_BYTES; \
            const float cd = CDp[(n)]; \
            bf16x8 Sb[2]; Sb[0] = pack8(S[0], S[1]); Sb[1] = pack8(S[2], S[3]); \
            f32x4 vn[4]; \
            _Pragma("unroll") for (int m = 0; m < 4; ++m) { f32x4 t = (f32x4){zz, zz, zz, zz}; \
                t = MFMA16(*(const bf16x8*)(buf + ((m * 2 + 0) * 64 + lane) * 16), Sb[0], t); t = MFMA16(*(const bf16x8*)(buf + ((m * 2 + 1) * 64 + lane) * 16), Sb[1], t); \
                const u32x2 uu = *(const u32x2*)(buf + 32768 + ((w * 4 + m) * 64 + lane) * 8); \
                vn[m] = (f32x4){bflo(uu.x), bfhi(uu.x), bflo(uu.y), bfhi(uu.y)} - t; } \
            bf16x8 vb[2]; vb[0] = pack8(vn[0], vn[1]); vb[1] = pack8(vn[2], vn[3]); \
            _Pragma("unroll") for (int kt = 0; kt < 4; ++kt) { f32x4 t = S[kt] * cd; \
                t = MFMA16(*(const bf16x8*)(buf + 24576 + ((kt * 2 + 0) * 64 + lane) * 16), vb[0], t); t = MFMA16(*(const bf16x8*)(buf + 24576 + ((kt * 2 + 1) * 64 + lane) * 16), vb[1], t); S[kt] = t; } \
            _Pragma("unroll") for (int m = 0; m < 4; ++m) { f32x4 t = (f32x4){zz, zz, zz, zz}; \
                t = MFMA16(*(const bf16x8*)(buf + 8192 + ((m * 2 + 0) * 64 + lane) * 16), Sb[0], t); t = MFMA16(*(const bf16x8*)(buf + 8192 + ((m * 2 + 1) * 64 + lane) * 16), Sb[1], t); \
                t = MFMA16(*(const bf16x8*)(buf + 16384 + ((m * 2 + 0) * 64 + lane) * 16), vb[0], t); t = MFMA16(*(const bf16x8*)(buf + 16384 + ((m * 2 + 1) * 64 + lane) * 16), vb[1], t); \
                *(f32x4*)(OX + ((n) & 1) * 16384 + ((w * 4 + m) * 64 + lane) * 16) = t; } \
        } else { \
            _Pragma("unroll") for (int q = 0; q < 4; ++q) _Pragma("unroll") for (int r = 0; r < 4; ++r) GZN[q][r] = DZ[((size_t)b * SEQL + (n) * 64 + 16 * (w - 4) + 4 * g + r) * 512 + h * 64 + 16 * q + c]; \
            if ((n) + 2 < 32) { _Pragma("unroll") for (int k = 0; k < 10; ++k) Y[k] = *(const u32x4*)(gsrc + (size_t)((n) + 2) * PREP_CHUNK_BYTES + (size_t)st * 16 + k * 4096); } \
            if ((n) >= 1) DN_FINAL((n) - 1, GZC); \
            if ((n) + 1 < 32) { _Pragma("unroll") for (int k = 0; k < 10; ++k) *(u32x4*)(lds + (((n) + 1) & 1) * PREP_CHUNK_BYTES + st * 16 + k * 4096) = X[k]; } \
        } \
        __syncthreads(); } while (0)
    for (int n = 0; n < 32; n += 2) { DN_STEP(n, stA, stB, gzB, gzA); DN_STEP(n + 1, stB, stA, gzA, gzB); }
    if (w >= 4) DN_FINAL(31, gzB);
#undef DN_STEP
#undef DN_FINAL
}

typedef short v4i16_t __attribute__((ext_vector_type(4)));
DI u32x2 trread(const bf16_t* p) { return __builtin_bit_cast(u32x2, __builtin_amdgcn_ds_read_tr16_b64_v4i16((__attribute__((address_space(3))) v4i16_t*)p)); }
DI void ret_scan_wg(const Params& p, int l, int bhi, unsigned char* lds, int tid) {
    const int bh = bhi >> 1, ih = bhi & 1;
    float zz = 0.f; unsigned zu = 0u; asm volatile("" : "+v"(zz), "+v"(zu));
    const int lane = tid & 63, w = tid >> 6, b = bh >> 2, h = bh & 3;
    constexpr int RB = 35840;
    float* red = (float*)(lds + 3 * RB);
    float* OT = (float*)(lds + 3 * RB + 4096);
    unsigned char* PA = lds + 3 * RB + 4096 + 33792;
    const int tokrow = tid >> 4, cp = tid & 15;
    const bf16_t* R = (const bf16_t*)(p.ws + OFF_R); bf16_t* BRC = (bf16_t*)(p.ws + OFF_DQKV) + (size_t)2 * MT * 512;
    const float lg = logf(1.f - exp2f(-5.f - (float)h)), cfac = expf(-64.f * lg), cdec = expf(64.f * lg);
    f32x4 S[4], out[2];
#pragma unroll
    for (int i = 0; i < 4; ++i) S[i] = (f32x4){zz, zz, zz, zz};
    out[0] = S[0]; out[1] = S[0];
    const int itA = ih ? 1 : 0, itB = ih ? 2 : 3;
    const int li = tid >> 3, ld0 = (tid & 7) * 8, lc0 = (tid & 7) * 16;
    const bf16_t* gsrc = R + ((size_t)b * SEQL + li) * 1536;
#define RET_LOAD(X, nn) do { const bf16_t* r_ = gsrc + (size_t)(nn) * 64 * 1536; X[0] = *(const u32x4*)(r_ + h * 64 + ld0); X[1] = *(const u32x4*)(r_ + 256 + h * 64 + ld0); \
        X[2] = *(const u32x4*)(r_ + 512 + h * 128 + lc0); X[3] = *(const u32x4*)(r_ + 512 + h * 128 + lc0 + 8); } while (0)
#define RET_STORE(X, bufi) do { bf16_t* B_ = (bf16_t*)(lds + (bufi) * RB); *(u32x4*)(B_ + li * 72 + ld0) = X[0]; *(u32x4*)(B_ + 64 * 72 + li * 72 + ld0) = X[1]; \
        *(u32x4*)(B_ + 128 * 72 + li * 136 + lc0) = X[2]; *(u32x4*)(B_ + 128 * 72 + li * 136 + lc0 + 8) = X[3]; } while (0)
    const int c_ = lane & 15, g_ = lane >> 4;
#define RET_PTILE(nn) do { const int e_ = w >> 2, jt_ = w & 3, it_ = e_ ? itB : itA; \
        const bf16_t* QDp = (const bf16_t*)(lds + ((nn) % 3) * RB); const bf16_t* KTp = QDp + 64 * 72; \
        f32x4 t = (f32x4){zz, zz, zz, zz}; \
        if (jt_ <= it_) { const bf16x8 q0 = *(const bf16x8*)(QDp + (16 * it_ + c_) * 72 + 8 * g_), q1 = *(const bf16x8*)(QDp + (16 * it_ + c_) * 72 + 32 + 8 * g_); \
            const bf16x8 k0 = *(const bf16x8*)(KTp + (16 * jt_ + c_) * 72 + 8 * g_), k1 = *(const bf16x8*)(KTp + (16 * jt_ + c_) * 72 + 32 + 8 * g_); \
            t = MFMA16(k0, q0, t); t = MFMA16(k1, q1, t); t = t * cfac; \
            if (jt_ == it_) { _Pragma("unroll") for (int r = 0; r < 4; ++r) t[r] = (4 * g_ + r <= c_) ? t[r] : 0.f; } } \
        u32x2 hv; hv.x = pk2(t[0], t[1]); hv.y = pk2(t[2], t[3]); \
        *(u32x2*)(PA + ((nn) & 1) * 4096 + ((e_ * 2 + (jt_ >> 1)) * 64 + lane) * 16 + (jt_ & 1) * 8) = hv; } while (0)
    u32x4 stA[4], stB[4];
    RET_LOAD(stA, 0); RET_LOAD(stB, 1); RET_STORE(stA, 0); RET_STORE(stB, 1); RET_LOAD(stA, 2);
    __syncthreads();
    RET_PTILE(0);
    __syncthreads();
#define RET_STEP(n, X, Y) do { \
        int c = c_, g = g_; asm volatile("" : "+v"(c), "+v"(g)); \
        const bf16_t* QD = (const bf16_t*)(lds + ((n) % 3) * RB); const bf16_t* KT = QD + 64 * 72; const bf16_t* VS = KT + 64 * 72; \
        const size_t tokp = (size_t)b * SEQL + ((n) - 1) * 64 + 16 * ((tokrow >> 4) ? itB : itA) + (tokrow & 15); \
        u32x4 gq = (u32x4){zu, zu, zu, zu}; if ((n) >= 1) gq = *(const u32x4*)(R + tokp * 1536 + 1024 + h * 128 + 8 * cp); \
        if ((n) + 3 < 32) RET_LOAD(Y, (n) + 3); \
        if ((n) + 1 < 32) RET_PTILE((n) + 1); \
        bf16x8 Vb[2], Sb[2]; \
        const int tq = c >> 2, tp = c & 3; \
        _Pragma("unroll") for (int s = 0; s < 2; ++s) { const bf16_t* vp = VS + (32 * s + 4 * g + tq) * 136 + 16 * w + 4 * tp; Vb[s] = cat8(trread(vp), trread(vp + 16 * 136)); } \
        Sb[0] = pack8(S[0], S[1]); Sb[1] = pack8(S[2], S[3]); \
        _Pragma("unroll") for (int e = 0; e < 2; ++e) { const int it = e ? itB : itA; \
            const unsigned char* pap = PA + ((n) & 1) * 4096 + (e * 2 * 64 + lane) * 16; \
            f32x4 o = (f32x4){zz, zz, zz, zz}; \
            o = MFMA16(*(const bf16x8*)pap, Vb[0], o); \
            if (it >= 2) o = MFMA16(*(const bf16x8*)(pap + 1024), Vb[1], o); \
            _Pragma("unroll") for (int s = 0; s < 2; ++s) { const bf16_t* qp = QD + (16 * it + c) * 72 + 32 * s + 4 * g; o = MFMA16(cat8(*(const u32x2*)qp, *(const u32x2*)(qp + 16)), Sb[s], o); } \
            out[e] = o; \
        } \
        _Pragma("unroll") for (int dt = 0; dt < 4; ++dt) { f32x4 t = S[dt] * cdec; \
            _Pragma("unroll") for (int s = 0; s < 2; ++s) { const bf16_t* kp = KT + (32 * s + 4 * g + tq) * 72 + 16 * dt + 4 * tp; t = MFMA16(cat8(trread(kp), trread(kp + 16 * 72)), Vb[s], t); } \
            S[dt] = t; } \
        float* rb = red + ((n) & 1) * 512; \
        _Pragma("unroll") for (int m = 0; m < 2; ++m) _Pragma("unroll") for (int r = 0; r < 4; ++r) { float q = out[m][r] * out[m][r]; ROW_SUM16(q); \
            if (c == 0) rb[w * 64 + 16 * m + 4 * g + r] = q; } \
        if ((n) + 2 < 32) RET_STORE(X, ((n) + 2) % 3); \
        __syncthreads(); \
        _Pragma("unroll") for (int m = 0; m < 2; ++m) { f32x4 tot = *(const f32x4*)(rb + 16 * m + 4 * g); \
            _Pragma("unroll") for (int q = 1; q < 8; ++q) tot = tot + *(const f32x4*)(rb + q * 64 + 16 * m + 4 * g); \
            _Pragma("unroll") for (int r = 0; r < 4; ++r) OT[((n) & 1) * 4224 + (16 * m + 4 * g + r) * 132 + 16 * w + c] = out[m][r] * rsqrtf(tot[r] * (1.f / 128.f) + EPSF); } \
        if ((n) >= 1) { const float* op = OT + (((n) - 1) & 1) * 4224 + tokrow * 132 + 8 * cp; const f32x4 a0 = *(const f32x4*)op, a1 = *(const f32x4*)(op + 4); float gg[8]; unpack8(gq, gg); \
            u32x4 wo; wo.x = pk2(a0[0] * gg[0], a0[1] * gg[1]); wo.y = pk2(a0[2] * gg[2], a0[3] * gg[3]); wo.z = pk2(a1[0] * gg[4], a1[1] * gg[5]); wo.w = pk2(a1[2] * gg[6], a1[3] * gg[7]); \
            *(u32x4*)(BRC + tokp * 512 + h * 128 + 8 * cp) = wo; } \
    } while (0)
    for (int n = 0; n < 32; n += 2) { RET_STEP(n, stA, stB); RET_STEP(n + 1, stB, stA); }
    __syncthreads();
    {
        const size_t tokp = (size_t)b * SEQL + 31 * 64 + 16 * ((tokrow >> 4) ? itB : itA) + (tokrow & 15);
        const u32x4 gq = *(const u32x4*)(R + tokp * 1536 + 1024 + h * 128 + 8 * cp);
        const float* op = OT + 4224 + tokrow * 132 + 8 * cp; const f32x4 a0 = *(const f32x4*)op, a1 = *(const f32x4*)(op + 4); float gg[8]; unpack8(gq, gg);
        u32x4 wo; wo.x = pk2(a0[0] * gg[0], a0[1] * gg[1]); wo.y = pk2(a0[2] * gg[2], a0[3] * gg[3]); wo.z = pk2(a1[0] * gg[4], a1[1] * gg[5]); wo.w = pk2(a1[2] * gg[6], a1[3] * gg[7]);
        *(u32x4*)(BRC + tokp * 512 + h * 128 + 8 * cp) = wo;
    }
#undef RET_STEP
#undef RET_PTILE
#undef RET_LOAD
#undef RET_STORE
}

DI void attn_item(const Params& p, int l, int item, unsigned char* lds, int tid) {
    float zz = 0.f; unsigned zu = 0u; asm volatile("" : "+v"(zz), "+v"(zu));
    const int kvh = item & 1, nb = (item >> 1) & 15, b = item >> 5, lane = tid & 63, wave = tid >> 6, c = lane & 15, g = lane >> 4;
    bf16_t* KS = (bf16_t*)lds; bf16_t* VT = KS + 256 * 72;
    const bf16_t* A = (const bf16_t*)(p.ws + OFF_AQKV); const float* TA = (const float*)(p.ws + OFF_TA); bf16_t* BRA = (bf16_t*)(p.ws + OFF_DQKV);
    const float* qn = p.in[9] + l * 64; const float* kn = p.in[10] + l * 64;
    {
        const int d0 = (tid & 7) * 8;
#pragma unroll
        for (int pz = 0; pz < 4; ++pz) { const int jj = pz * 64 + (tid >> 3), pos = (nb - 1) * 128 + jj;
            float k[8]; u32x4 vv = (u32x4){zu, zu, zu, zu};
            if (pos >= 0) { const size_t tok = (size_t)b * SEQL + pos; unpack8(*(const u32x4*)(A + tok * 768 + 512 + kvh * 64 + d0), k); vv = *(const u32x4*)(A + tok * 768 + 640 + kvh * 64 + d0); }
            else { for (int e = 0; e < 8; ++e) k[e] = 0.f; }
            float ss = 0.f;
#pragma unroll
            for (int e = 0; e < 8; ++e) ss += k[e] * k[e];
            ss += __shfl_xor(ss, 1); ss += __shfl_xor(ss, 2); ss += __shfl_xor(ss, 4);
            const float r = rsqrtf(ss * (1.f / 64.f) + EPSF);
            float part[8];
#pragma unroll
            for (int e = 0; e < 8; ++e) { k[e] = k[e] * r * kn[d0 + e]; part[e] = __shfl_xor(k[e], 1); }
            if (d0 < 16 && pos >= 0) {
#pragma unroll
                for (int e = 0; e < 8; ++e) { const float cs = TA[(pos * 8 + e) * 2], sn = TA[(pos * 8 + e) * 2 + 1];
                    k[e] = (d0 == 0) ? (k[e] * cs - part[e] * sn) : (k[e] * cs + part[e] * sn); } }
            u32x4 wk; wk.x = pk2(k[0], k[1]); wk.y = pk2(k[2], k[3]); wk.z = pk2(k[4], k[5]); wk.w = pk2(k[6], k[7]);
            *(u32x4*)(KS + jj * 72 + d0) = wk;
            const unsigned vw[4] = {vv.x, vv.y, vv.z, vv.w};
#pragma unroll
            for (int e = 0; e < 4; ++e) { VT[(d0 + 2 * e) * 264 + jj] = (bf16_t)(vw[e] & 0xffffu); VT[(d0 + 2 * e + 1) * 264 + jj] = (bf16_t)(vw[e] >> 16); }
        }
    }
    __syncthreads();
    const int hq = kvh * 4 + (wave >> 1); const float sink = p.in[11][l * 8 + hq];
    for (int ai = 0; ai < 4; ++ai) { const int a = (wave & 1) * 4 + ai;
        const int pos = nb * 128 + 16 * a + c; const size_t tok = (size_t)b * SEQL + pos;
        float q[16]; unpack8(*(const u32x4*)(A + tok * 768 + hq * 64 + 8 * g), q); unpack8(*(const u32x4*)(A + tok * 768 + hq * 64 + 32 + 8 * g), q + 8);
        float ss = 0.f;
#pragma unroll
        for (int e = 0; e < 16; ++e) ss += q[e] * q[e];
        ss += __shfl_xor(ss, 16); ss += __shfl_xor(ss, 32);
        const float r = rsqrtf(ss * (1.f / 64.f) + EPSF);
#pragma unroll
        for (int e = 0; e < 8; ++e) { q[e] = q[e] * r * qn[8 * g + e]; q[8 + e] = q[8 + e] * r * qn[32 + 8 * g + e]; }
        float part[8];
#pragma unroll
        for (int e = 0; e < 8; ++e) part[e] = __shfl_xor(q[e], 16);
        if (g < 2) {
#pragma unroll
            for (int e = 0; e < 8; ++e) { const float cs = TA[(pos * 8 + e) * 2], sn = TA[(pos * 8 + e) * 2 + 1];
                q[e] = (g == 0) ? (q[e] * cs - part[e] * sn) : (q[e] * cs + part[e] * sn); } }
        bf16x8 qb[2];
        { u32x4 w0, w1; w0.x = pk2(q[0] * .125f, q[1] * .125f); w0.y = pk2(q[2] * .125f, q[3] * .125f); w0.z = pk2(q[4] * .125f, q[5] * .125f); w0.w = pk2(q[6] * .125f, q[7] * .125f);
          w1.x = pk2(q[8] * .125f, q[9] * .125f); w1.y = pk2(q[10] * .125f, q[11] * .125f); w1.z = pk2(q[12] * .125f, q[13] * .125f); w1.w = pk2(q[14] * .125f, q[15] * .125f);
          qb[0] = __builtin_bit_cast(bf16x8, w0); qb[1] = __builtin_bit_cast(bf16x8, w1); }
        f32x4 P[10]; float mx = sink;
#pragma unroll
        for (int jp = 0; jp < 9; ++jp) { const int jt = a + jp;
            const bf16x8 k0 = *(const bf16x8*)(KS + (16 * jt + c) * 72 + 8 * g), k1 = *(const bf16x8*)(KS + (16 * jt + c) * 72 + 32 + 8 * g);
            f32x4 t = (f32x4){zz, zz, zz, zz}; t = MFMA16(k0, qb[0], t); t = MFMA16(k1, qb[1], t);
#pragma unroll
            for (int rr = 0; rr < 4; ++rr) { const int kj = 16 * jt + 4 * g + rr, qi = 16 * a + c; const bool ok = (kj > qi) && (kj <= qi + 128) && (nb > 0 || kj >= 128);
                t[rr] = ok ? t[rr] : -1e30f; mx = fmaxf(mx, t[rr]); }
            P[jp] = t; }
        P[9] = (f32x4){zz, zz, zz, zz};
        mx = fmaxf(mx, __shfl_xor(mx, 16)); mx = fmaxf(mx, __shfl_xor(mx, 32));
        float sum = 0.f;
#pragma unroll
        for (int jp = 0; jp < 9; ++jp)
#pragma unroll
            for (int rr = 0; rr < 4; ++rr) { const float e = __expf(P[jp][rr] - mx); P[jp][rr] = e; sum += e; }
        sum += __shfl_xor(sum, 16); sum += __shfl_xor(sum, 32);
        const float inv = 1.f / (sum + __expf(sink - mx));
#pragma unroll
        for (int jp = 0; jp < 9; ++jp) P[jp] = P[jp] * inv;
        f32x4 o[4];
#pragma unroll
        for (int nt = 0; nt < 4; ++nt) o[nt] = (f32x4){zz, zz, zz, zz};
#pragma unroll
        for (int s = 0; s < 5; ++s) { const bf16x8 pa = pack8(P[2 * s], P[2 * s + 1]);
#pragma unroll
            for (int nt = 0; nt < 4; ++nt) { const bf16_t* vp = VT + (16 * nt + c) * 264 + 16 * (a + 2 * s) + 4 * g;
                const u32x2 lo = *(const u32x2*)vp; const u32x2 hi = (s < 4) ? *(const u32x2*)(vp + 16) : (u32x2){zu, zu};
                o[nt] = MFMA16(pa, cat8(lo, hi), o[nt]); } }
#pragma unroll
        for (int nt = 0; nt < 4; ++nt)
#pragma unroll
            for (int rr = 0; rr < 4; ++rr) { const size_t tk = (size_t)b * SEQL + nb * 128 + 16 * a + 4 * g + rr; BRA[tk * 512 + hq * 64 + 16 * nt + c] = (bf16_t)f2bf(o[nt][rr]); }
    }
    __syncthreads();
}
constexpr int N_PHASES = 25;
#ifndef COOP
#define COOP 1
#endif
DI void fast_grid_barrier(unsigned* ctr, unsigned target) {
    asm volatile("s_waitcnt vmcnt(0)" ::: "memory");
    __syncthreads();
    if (threadIdx.x == 0) {
        __builtin_amdgcn_fence(__ATOMIC_RELEASE, "agent");
        asm volatile("s_waitcnt vmcnt(0)" ::: "memory");
        __hip_atomic_fetch_add(ctr, 1u, __ATOMIC_RELAXED, __HIP_MEMORY_SCOPE_AGENT);
        while (__hip_atomic_load(ctr, __ATOMIC_RELAXED, __HIP_MEMORY_SCOPE_AGENT) < target) __builtin_amdgcn_s_sleep(1);
        __builtin_amdgcn_fence(__ATOMIC_ACQUIRE, "agent");
        asm volatile("s_waitcnt vmcnt(0)" ::: "memory");
    }
    __syncthreads();
}
__global__ void __launch_bounds__(512, 2) mega_fwd(Params p) {
    extern __shared__ __attribute__((aligned(16))) unsigned char lds_raw[];
    const int G0 = gridDim.x, bx0 = blockIdx.x, wv0 = __builtin_amdgcn_readfirstlane((int)(threadIdx.x >> 6)); unsigned nbar = 0;
#ifndef REP_S
#define REP_S -1
#define REP_N 0
#endif
#ifndef REP_L
#define REP_L -1
#endif
    for (int phx = p.ph_lo * (1 + REP_N); phx < p.ph_hi * (1 + REP_N); ++phx) {
        const int ph = phx / (1 + REP_N);
        if (REP_N > 0 && (phx % (1 + REP_N)) != 0 && !(ph > 0 && (ph - 1) % 12 == REP_S && (REP_L < 0 || (ph - 1) / 12 == REP_L))) continue;
        if (phx > p.ph_lo * (1 + REP_N)) {
            if (phx == p.ph_lo * (1 + REP_N) + 1) cg::this_grid().sync();
            else { ++nbar; fast_grid_barrier((unsigned*)(p.ws + OFF_CTR), nbar * (unsigned)G0); }
        }
#ifdef SYNC_ONLY
        if ((phx % (1 + REP_N)) != 0) continue;
#endif
        typedef __attribute__((address_space(4))) const Params* KP;
        KP kp = (KP)__builtin_amdgcn_kernarg_segment_ptr();
        int wvi = wv0; asm volatile("" : "+s"(wvi));
        unsigned ones = ~0u; asm volatile("" : "+s"(ones));
        int tid = wvi * 64 + (int)__builtin_amdgcn_mbcnt_hi(ones, __builtin_amdgcn_mbcnt_lo(ones, 0u)), G = G0, bx = bx0;
        asm volatile("" : "+v"(tid), "+s"(G), "+s"(bx), "+s"(kp) :: "memory");
        const Params& P = *(const Params*)kp; unsigned char* ws = P.ws;
        PG8_LAS unsigned char* ldsl = (PG8_LAS unsigned char*)lds_raw; asm volatile("" : "+v"(ldsl));
        unsigned char* lds = (unsigned char*)ldsl;
        float* MOD = (float*)(ws + OFF_MOD);
        if (ph == 0) { phase_mod(P, lds, tid); continue; }
        const int q = ph - 1, l = q / 12, s = q % 12;
        const float* xsrc = (l == 0 && s <= 2) ? P.in[0] : P.out;
        float* modl = MOD + (size_t)l * 8 * NMODW;
        if (s == 0 || s == 3 || s == 9) { phase_prep(P, l, s == 0 ? 0 : (s == 3 ? 1 : 2), xsrc, lds, tid); }
        else if (s == 1 || s == 10) {
            pg8::Gemm g{(const bf16_t*)(ws + OFF_U), (const bf16_t*)(ws + OFF_W13T), MT, 2 * DFF, DM}; pg8::StaticOrder S; S.init(MT, 2 * DFF, G, bx);
            EpiSwiGLU E{(bf16_t*)(ws + OFF_H)};
            pg8::gemm_phase<EpiSwiGLU, pg8::StaticOrder, true, true>(ldsl, g, S, E, tid);
        } else if (s == 2 || s == 8 || s == 11) {
            pg8::Gemm g{(const bf16_t*)(ws + (s == 8 ? OFF_U : OFF_H)), (const bf16_t*)(ws + (s == 8 ? OFF_WOT : OFF_W2T)), MT, DM, s == 8 ? DM : DFF}; pg8::StaticOrder S; S.init(MT, DM, G, bx);
            EpiResid E{xsrc, P.out, modl + (s == 2 ? 2 : (s == 8 ? 5 : 8)) * DM, s == 8 ? 1.f : 0.5f};
            pg8::gemm_phase<EpiResid, pg8::StaticOrder, false, true>(ldsl, g, S, E, tid);
        } else if (s == 4) {
            pg8::Gemm g{(const bf16_t*)(ws + OFF_U), (const bf16_t*)(ws + OFF_WINT), MT, NPROJ, DM}; pg8::StaticOrder S; S.init(MT, NPROJ, G, bx);
            EpiProj E{ws};
            pg8::gemm_phase<EpiProj, pg8::StaticOrder, true, true>(ldsl, g, S, E, tid);
        } else if (s == 5) {
            { u32x4 pre[12]; dn_prep_fetch(P, bx < 2048 ? bx : 0, tid, pre);
              for (int it = bx; it < 2048; it += G) { int tl = tid; asm volatile("" : "+v"(tl)); dn_prep_item(P, l, it, it + G, pre, lds, tl); } }
        } else if (s == 6) {
            const int stride = (G > 192) ? ((bx < 128) ? (1 << 20) : (G - 128)) : G;
            for (int it = bx; it < 384; it += stride) {
                int tl = tid; asm volatile("" : "+v"(tl));
#ifdef ROLE_ONLY
                if ((phx % (1 + REP_N)) != 0 && (it < 64 ? 0 : (it < 128 ? 1 : 2)) != ROLE_ONLY) continue;
#endif
                if (it < 64) dn_scan_wg(P, l, it, lds, tl);
                else if (it < 128) ret_scan_wg(P, l, it - 64, lds, tl);
                else attn_item(P, l, it - 128, lds, tl);
                __syncthreads();
            }
        } else if (s == 7) {
            pg8::Gemm g{(const bf16_t*)(ws + OFF_DQKV), (const bf16_t*)(ws + OFF_WBT), 3 * MT, 3 * DM, 512}; MergeOrder S{G, bx};
            EpiMerge E{(const bf16_t*)(ws + OFF_GATES), (bf16_t*)(ws + OFF_U)};
            pg8::gemm_phase<EpiMerge, MergeOrder, true, true>(ldsl, g, S, E, tid);
        }
    }
}

extern "C" void kernel_launch(void* const* d_in, const int* in_sizes, int n_in, void* d_out, int out_size, void* d_ws, size_t ws_size, hipStream_t stream) {
    static int grid = 0;
    if (grid == 0) {
        int dev = 0, cus = 0, per_cu = 0;
        hipGetDevice(&dev); hipDeviceGetAttribute(&cus, hipDeviceAttributeMultiprocessorCount, dev);
        hipFuncSetAttribute((const void*)mega_fwd, hipFuncAttributeMaxDynamicSharedMemorySize, LDS_BYTES);
        hipOccupancyMaxActiveBlocksPerMultiprocessor(&per_cu, (const void*)mega_fwd, 512, LDS_BYTES);
        if (per_cu < 1) per_cu = 1;
        grid = cus * per_cu; if (grid > 256) grid = 256;
        if (ws_size < WS_END) fprintf(stderr, "kernel_launch: workspace too small: %zu < %zu\n", ws_size, (size_t)WS_END);
        (void)hipGetLastError();
    }
    hipMemsetAsync((unsigned char*)d_ws + OFF_CTR, 0, 256, stream);
    Params p{};
    for (int i = 0; i < 21; ++i) p.in[i] = (const float*)d_in[i];
    p.out = (float*)d_out; p.ws = (unsigned char*)d_ws;
#if COOP
    p.ph_lo = 0; p.ph_hi = N_PHASES;
    void* args[] = {&p};
    hipError_t e = hipLaunchCooperativeKernel((const void*)mega_fwd, dim3(grid), dim3(512), args, LDS_BYTES, stream);
    if (e != hipSuccess) fprintf(stderr, "cooperative launch failed: %s (grid %d)\n", hipGetErrorString(e), grid);
#else
    for (int ph = 0; ph < N_PHASES; ++ph) { p.ph_lo = ph; p.ph_hi = ph + 1; hipLaunchKernelGGL(mega_fwd, dim3(grid), dim3(512), LDS_BYTES, stream, p); }
#endif
}
```

```cpp
#include <hip/hip_runtime.h>
#include <hip/hip_cooperative_groups.h>
#include <cstdio>
#include <cstdint>
namespace pg8 {
#define PG8_LAS __attribute__((address_space(3)))
typedef unsigned short bf16_t;
typedef short bf16x8 __attribute__((ext_vector_type(8)));
typedef float f32x4 __attribute__((ext_vector_type(4)));
typedef unsigned u32x4 __attribute__((ext_vector_type(4)));
constexpr int BM = 256, BK = 64, HALF = 128, HTB = HALF * BK * 2  , STAGE_BYTES = 8 * HTB, NXCD = 8, WGM = 8;

__host__ __device__ __forceinline__ int lds_byte(int r, int c) { const int st = (r >> 4) * 2 + (c >> 5), rr = r & 15, cc = c & 31, ob = rr * 64 + cc * 2; return st * 1024 + (ob ^ (((ob >> 9) & 1) << 5)); }
__host__ __device__ __forceinline__ void stage_rc(int b, int& R, int& C) { const int st = b / 1024, sb = b % 1024, swz = sb ^ (((sb >> 9) & 1) << 5); R = (st >> 1) * 16 + swz / 64; C = (st & 1) * 32 + (swz % 64) / 2; }
__host__ __device__ __forceinline__ int perm32(int rho) { const int n = rho >> 4, i = rho & 15; return 8 * (i >> 2) + 4 * n + (i & 3); }

struct Unit { int pm, pn; };
struct Gemm { const bf16_t* A; const bf16_t* Bt; int M, N, K; };

struct StaticOrder {
    int nM, nN, nwg, G, c;
    __host__ __device__ void init(int M, int N, int G_, int c_) { nM = M / BM; nN = N / BM; nwg = nM * nN; G = G_; c = c_; }
    __host__ __device__ bool next(int i, Unit& u) const {
        const long L = (long)i * G + c; if (L >= nwg) return false;
        int wgid = (int)L; { const int q = nwg / NXCD, r = nwg % NXCD, xcd = wgid % NXCD, off = wgid / NXCD; wgid = (xcd < r ? xcd * (q + 1) : r * (q + 1) + (xcd - r) * q) + off; }
        const int nig = WGM * nN, gid = wgid / nig, fm = gid * WGM, gsz = (nM - fm) < WGM ? (nM - fm) : WGM;
        u.pm = fm + ((wgid % nig) % gsz); u.pn = (wgid % nig) / gsz; return true;
    }
    __device__ __forceinline__ void a_ready(const Unit&) const {}
    __device__ __forceinline__ void done(const Unit&) const {}
};

__device__ __forceinline__ unsigned cvt_pk_bf16(float lo, float hi) { unsigned r; asm volatile("v_cvt_pk_bf16_f32 %0, %1, %2" : "=v"(r) : "v"(lo), "v"(hi)); return r; }
typedef float f32x2 __attribute__((ext_vector_type(2)));
template <class Epi, class Sched, bool ALIGN_EPI = false, bool SP2 = false>
__device__ __forceinline__ void gemm_phase(PG8_LAS unsigned char* lds, const Gemm g, const Sched& S, const Epi& E, const int tid) {
    const int wid = __builtin_amdgcn_readfirstlane(tid >> 6), lane = tid & 63, wr = wid >> 2, wc = wid & 3, fr = lane & 15, fq = lane >> 4;
    const int K = g.K, nt = K / BK; float zz = 0.f; asm volatile("" : "+v"(zz));
    unsigned voffA[2], voffB[2];
#pragma unroll
    for (int i = 0; i < 2; ++i) { int R, C; stage_rc(tid * 16 + i * 8192, R, C); const int Rb = Epi::PERM ? ((R & ~31) + perm32(R & 31)) : R;
        voffA[i] = (unsigned)(R * K + C) * 2u; voffB[i] = (unsigned)(Rb * K + C) * 2u; }
    const size_t kstep = (size_t)(BK * 2);
    const size_t hstep = (size_t)HALF * K * 2;
    const size_t tstep = 2 * hstep;
    const unsigned ldsw = (unsigned)wid * 1024u;
    const int aoff = lds_byte(wr * 64 + fr, fq * 8), boff = lds_byte(wc * 32 + fr, fq * 8);
#define PG8_SA(b, h) (((b) * 2 + (h)) * HTB)
#define PG8_SB(b, h) ((4 + (b) * 2 + (h)) * HTB)
#define PG8_STAGE(bufoff, gbase, voff) do { _Pragma("unroll") for (int _i = 0; _i < 2; ++_i) \
        __builtin_amdgcn_global_load_lds((const unsigned*)((const char*)(gbase) + (voff)[_i]), (PG8_LAS unsigned*)(lds + (bufoff) + ldsw + _i * 8192), 16, 0, 0); } while (0)
#define PG8_LDA(dst, b, h) do { _Pragma("unroll") for (int m = 0; m < 4; ++m) _Pragma("unroll") for (int k = 0; k < 2; ++k) dst[m][k] = *(const PG8_LAS bf16x8*)(lds + PG8_SA(b, h) + aoff + m * 2048 + k * 1024); } while (0)
#define PG8_LDB(dst, b, h) do { _Pragma("unroll") for (int n = 0; n < 2; ++n) _Pragma("unroll") for (int k = 0; k < 2; ++k) dst[n][k] = *(const PG8_LAS bf16x8*)(lds + PG8_SB(b, h) + boff + n * 2048 + k * 1024); } while (0)
#define PG8_MMA(ai, bj, At, Bt) do { __builtin_amdgcn_s_setprio(1); _Pragma("unroll") for (int m = 0; m < 4; ++m) _Pragma("unroll") for (int n = 0; n < 2; ++n) _Pragma("unroll") for (int k = 0; k < 2; ++k) \
        acc[ai][bj][m][n] = __builtin_amdgcn_mfma_f32_16x16x32_bf16(Bt[n][k], At[m][k], acc[ai][bj][m][n], 0, 0, 0); __builtin_amdgcn_s_setprio(0); } while (0)
#define PG8_WAIT_V(n) asm volatile("s_waitcnt vmcnt(" #n ")" ::: "memory")
#define PG8_WAIT_L(n) asm volatile("s_waitcnt lgkmcnt(" #n ")" ::: "memory")
#define PG8_BAR __builtin_amdgcn_s_barrier()
#define PG8_SCHED __builtin_amdgcn_sched_barrier(0)
    Unit cur, nxt; int ui = 0;
    if (!S.next(0, cur)) return;
    f32x4 acc[2][2][4][2];
#pragma unroll
    for (int a = 0; a < 2; ++a)
#pragma unroll
        for (int b = 0; b < 2; ++b)
#pragma unroll
            for (int m = 0; m < 4; ++m)
#pragma unroll
                for (int n = 0; n < 2; ++n) acc[a][b][m][n] = (f32x4){zz, zz, zz, zz};
    bf16x8 At[4][2], B0[2][2], B1[2][2];
    const char* cA = (const char*)g.A + (size_t)cur.pm * tstep; const char* cB = (const char*)g.Bt + (size_t)cur.pn * tstep;
    S.a_ready(cur);
    if constexpr (SP2) {
        PG8_STAGE(PG8_SB(0, 0), cB, voffB); PG8_STAGE(PG8_SB(0, 1), cB + hstep, voffB); PG8_STAGE(PG8_SA(0, 0), cA, voffA); PG8_STAGE(PG8_SA(0, 1), cA + hstep, voffA);
        if (wr == 1) PG8_BAR;
        PG8_WAIT_V(2); PG8_BAR;
        PG8_STAGE(PG8_SB(1, 0), cB + kstep, voffB); PG8_STAGE(PG8_SA(1, 0), cA + kstep, voffA); PG8_STAGE(PG8_SB(1, 1), cB + hstep + kstep, voffB);
        PG8_WAIT_V(6); PG8_BAR;
    } else {
        PG8_STAGE(PG8_SB(0, 0), cB, voffB); PG8_STAGE(PG8_SA(0, 0), cA, voffA); PG8_STAGE(PG8_SB(0, 1), cB + hstep, voffB); PG8_STAGE(PG8_SA(0, 1), cA + hstep, voffA);
        if (wr == 1) PG8_BAR;
        PG8_WAIT_V(4); PG8_BAR;
        PG8_STAGE(PG8_SB(1, 0), cB + kstep, voffB); PG8_STAGE(PG8_SA(1, 0), cA + kstep, voffA); PG8_STAGE(PG8_SB(1, 1), cB + hstep + kstep, voffB);
        PG8_WAIT_V(6); PG8_BAR;
    }
    for (;;) {
        const bool has_next = S.next(ui + 1, nxt);
        const char* nA = has_next ? (const char*)g.A + (size_t)nxt.pm * tstep : cA; const char* nB = has_next ? (const char*)g.Bt + (size_t)nxt.pn * tstep : cB;
        for (int t = 0; t < nt; t += 2) {
            const bool last = (t == nt - 2);
            const char* a1 = cA + (size_t)(t + 1) * kstep;
            const char* a2 = last ? nA : cA + (size_t)(t + 2) * kstep; const char* b2 = last ? nB : cB + (size_t)(t + 2) * kstep;
            const char* a3 = a2 + kstep; const char* b3 = b2 + kstep;
            if (last && has_next) S.a_ready(nxt);
            if constexpr (SP2) {
            PG8_LDB(B0, 0, 0); PG8_LDB(B1, 0, 1); PG8_SCHED; PG8_LDA(At, 0, 0); PG8_STAGE(PG8_SA(1, 1), a1 + hstep, voffA);
            PG8_WAIT_V(8); PG8_WAIT_L(0); PG8_BAR; PG8_MMA(0, 0, At, B0); PG8_MMA(0, 1, At, B1); PG8_BAR; PG8_SCHED;
            PG8_LDA(At, 0, 1); PG8_STAGE(PG8_SB(0, 0), b2, voffB); PG8_STAGE(PG8_SB(0, 1), b2 + hstep, voffB); PG8_STAGE(PG8_SA(0, 0), a2, voffA);
            PG8_WAIT_V(8); PG8_WAIT_L(0); PG8_BAR; PG8_MMA(1, 0, At, B0); PG8_MMA(1, 1, At, B1); PG8_BAR; PG8_SCHED;
            PG8_LDB(B0, 1, 0); PG8_LDB(B1, 1, 1); PG8_SCHED; PG8_LDA(At, 1, 0); PG8_STAGE(PG8_SA(0, 1), a2 + hstep, voffA);
            PG8_WAIT_V(8); PG8_WAIT_L(0); PG8_BAR; PG8_MMA(0, 0, At, B0); PG8_MMA(0, 1, At, B1); PG8_BAR; PG8_SCHED;
            PG8_LDA(At, 1, 1); PG8_STAGE(PG8_SB(1, 0), b3, voffB); PG8_STAGE(PG8_SB(1, 1), b3 + hstep, voffB); PG8_STAGE(PG8_SA(1, 0), a3, voffA);
            PG8_WAIT_V(8); PG8_WAIT_L(0); PG8_BAR; PG8_MMA(1, 0, At, B0); PG8_MMA(1, 1, At, B1); PG8_BAR; PG8_SCHED;
            } else {
            PG8_LDB(B0, 0, 0); PG8_SCHED; PG8_LDA(At, 0, 0); PG8_STAGE(PG8_SA(1, 1), a1 + hstep, voffA);
            PG8_WAIT_L(8); PG8_BAR; PG8_WAIT_L(0); PG8_MMA(0, 0, At, B0); PG8_BAR; PG8_SCHED;
            PG8_LDB(B1, 0, 1); PG8_STAGE(PG8_SB(0, 0), b2, voffB);
            PG8_BAR; PG8_WAIT_L(0); PG8_MMA(0, 1, At, B1); PG8_BAR;
            PG8_LDA(At, 0, 1); PG8_STAGE(PG8_SA(0, 0), a2, voffA);
            PG8_BAR; PG8_WAIT_L(0); PG8_MMA(1, 0, At, B0); PG8_BAR; PG8_SCHED;
            PG8_STAGE(PG8_SB(0, 1), b2 + hstep, voffB);
            PG8_WAIT_V(6); PG8_BAR; PG8_MMA(1, 1, At, B1); PG8_BAR;
            PG8_LDB(B0, 1, 0); PG8_SCHED; PG8_LDA(At, 1, 0); PG8_STAGE(PG8_SA(0, 1), a2 + hstep, voffA);
            PG8_WAIT_L(8); PG8_BAR; PG8_WAIT_L(0); PG8_MMA(0, 0, At, B0); PG8_BAR; PG8_SCHED;
            PG8_LDB(B1, 1, 1); PG8_STAGE(PG8_SB(1, 0), b3, voffB);
            PG8_BAR; PG8_WAIT_L(0); PG8_MMA(0, 1, At, B1); PG8_BAR;
            PG8_LDA(At, 1, 1); PG8_STAGE(PG8_SA(1, 0), a3, voffA);
            PG8_BAR; PG8_WAIT_L(0); PG8_MMA(1, 0, At, B0); PG8_BAR; PG8_SCHED;
            PG8_STAGE(PG8_SB(1, 1), b3 + hstep, voffB);
            PG8_WAIT_V(6); PG8_BAR; PG8_MMA(1, 1, At, B1); PG8_BAR;
            }
        }
        if constexpr (ALIGN_EPI) { if (wr == 0) PG8_BAR; }
        if constexpr (!Epi::AFTER_DRAIN) { E(acc, cur, wr, wc, fr, fq); S.done(cur); }
        if (!has_next) break;
        if (E.zero_after(cur)) {
#pragma unroll
        for (int a = 0; a < 2; ++a)
#pragma unroll
            for (int b = 0; b < 2; ++b)
#pragma unroll
                for (int m = 0; m < 4; ++m)
#pragma unroll
                    for (int n = 0; n < 2; ++n) acc[a][b][m][n] = (f32x4){zz, zz, zz, zz};
        }
        cur = nxt; cA = nA; cB = nB; ++ui;
        if constexpr (ALIGN_EPI) { if (wr == 1) PG8_BAR; }
    }
    PG8_WAIT_V(0);
    if constexpr (!ALIGN_EPI) { if (wr == 0) PG8_BAR; }
    PG8_BAR;
    if constexpr (Epi::AFTER_DRAIN) { E.fused(acc, cur, wr, wc, fr, fq, lds, wid, lane); S.done(cur); }
#undef PG8_SA
#undef PG8_SB
#undef PG8_STAGE
#undef PG8_LDA
#undef PG8_LDB
#undef PG8_MMA
#undef PG8_WAIT_V
#undef PG8_WAIT_L
#undef PG8_BAR
#undef PG8_SCHED
}
}
namespace cg = cooperative_groups;
using pg8::bf16_t; using pg8::bf16x8; using pg8::f32x4; using pg8::u32x4; using pg8::Unit;
typedef unsigned u32x2 __attribute__((ext_vector_type(2)));
#define DI __device__ __forceinline__
#define MFMA16(a, b, c) __builtin_amdgcn_mfma_f32_16x16x32_bf16((a), (b), (c), 0, 0, 0)

constexpr int MT = 16384, DM = 1024, SEQL = 2048, DFF = 2816, NPROJ = 7680, NMODW = 9216;
constexpr float EPSF = 1e-6f;
constexpr size_t OFF_CTR = 3u << 20;
constexpr size_t OFF_MOD = 0, OFF_TA = 1u << 20, OFF_TR = OFF_TA + 131072, OFF_CD = OFF_TR + 524288, OFF_DAB = 2u << 20;
constexpr size_t OFF_W = 4u << 20, OFF_U = OFF_W + 22544384, OFF_BIG = OFF_U + 83886080;
constexpr size_t OFF_H = OFF_BIG, OFF_AQKV = OFF_BIG, OFF_DQKV = OFF_AQKV + 25165824, OFF_DZ = OFF_DQKV + 50331648;
constexpr size_t OFF_R = OFF_DZ + 16777216, OFF_GATES = OFF_R + 50331648, WS_END = OFF_GATES + 100663296;
constexpr size_t OFF_WBT = OFF_W, OFF_WOT = OFF_W + 3145728, OFF_W13T = OFF_W + 5242880, OFF_W2T = OFF_W + 16777216;
constexpr size_t OFF_WINT = OFF_U + 33554432;
constexpr int LDS_BYTES = 159744;

struct Params { const float* in[21]; float* out; unsigned char* ws; int ph_lo, ph_hi; };

DI unsigned f2bf(float f) { unsigned u = __builtin_bit_cast(unsigned, f); return (u + 0x7fffu + ((u >> 16) & 1u)) >> 16; }
typedef float f32x2_t __attribute__((ext_vector_type(2))); typedef __bf16 bf16x2_t __attribute__((ext_vector_type(2)));
DI unsigned pk2(float lo, float hi) { f32x2_t v = {lo, hi}; bf16x2_t b = __builtin_convertvector(v, bf16x2_t); return __builtin_bit_cast(unsigned, b); }
#define dpp_f(x, ctrl) __builtin_bit_cast(float, __builtin_amdgcn_update_dpp(0, __builtin_bit_cast(int, (x)), (ctrl), 0xf, 0xf, false))
#define ROW_SUM16(x) do { x += dpp_f(x, 0xB1); x += dpp_f(x, 0x4E); x += dpp_f(x, 0x141); x += dpp_f(x, 0x140); } while (0)
DI float bflo(unsigned w) { return __builtin_bit_cast(float, w << 16); }
DI float bfhi(unsigned w) { return __builtin_bit_cast(float, w & 0xffff0000u); }
DI float bf1(bf16_t h) { return __builtin_bit_cast(float, (unsigned)h << 16); }
DI float silu_f(float x) { return x * __builtin_amdgcn_rcpf(1.f + __builtin_amdgcn_exp2f(-1.4426950408889634f * x)); }
DI float sigm_f(float x) { return __builtin_amdgcn_rcpf(1.f + __builtin_amdgcn_exp2f(-1.4426950408889634f * x)); }
DI bf16x8 pack8(f32x4 a, f32x4 b) { u32x4 w; w.x = pk2(a[0], a[1]); w.y = pk2(a[2], a[3]); w.z = pk2(b[0], b[1]); w.w = pk2(b[2], b[3]); return __builtin_bit_cast(bf16x8, w); }
DI bf16x8 cat8(u32x2 a, u32x2 b) { u32x4 w; w.x = a.x; w.y = a.y; w.z = b.x; w.w = b.y; return __builtin_bit_cast(bf16x8, w); }
DI void unpack8(u32x4 w, float* f) { f[0] = bflo(w.x); f[1] = bfhi(w.x); f[2] = bflo(w.y); f[3] = bfhi(w.y); f[4] = bflo(w.z); f[5] = bfhi(w.z); f[6] = bflo(w.w); f[7] = bfhi(w.w); }

struct EpiSwiGLU { static constexpr bool PERM = true, AFTER_DRAIN = false; bf16_t* H;
    DI bool zero_after(const Unit&) const { return true; }
    DI void operator()(const f32x4 (&acc)[2][2][4][2], const Unit& u, int wr, int wc, int fr, int fq) const {
        const int row0 = u.pm * 256 + wr * 64 + fr, col0 = u.pn * 128 + wc * 32 + 8 * fq;
#pragma unroll
        for (int ai = 0; ai < 2; ++ai)
#pragma unroll
            for (int m = 0; m < 4; ++m) { bf16_t* p = H + (size_t)(row0 + ai * 128 + m * 16) * DFF + col0;
                const f32x4 g0 = acc[ai][0][m][0], g1 = acc[ai][0][m][1], u0 = acc[ai][1][m][0], u1 = acc[ai][1][m][1];
                u32x4 w; w.x = pk2(silu_f(g0[0]) * u0[0], silu_f(g0[1]) * u0[1]); w.y = pk2(silu_f(g0[2]) * u0[2], silu_f(g0[3]) * u0[3]);
                w.z = pk2(silu_f(g1[0]) * u1[0], silu_f(g1[1]) * u1[1]); w.w = pk2(silu_f(g1[2]) * u1[2], silu_f(g1[3]) * u1[3]);
                *(u32x4*)p = w; }
    } };
struct EpiResid { static constexpr bool PERM = true, AFTER_DRAIN = false; const float* src; float* dst; const float* modv; float gs;
    DI bool zero_after(const Unit&) const { return true; }
    DI void operator()(const f32x4 (&acc)[2][2][4][2], const Unit& u, int wr, int wc, int fr, int fq) const {
        asm volatile("" : "+v"(fr), "+v"(fq));
        const int row0 = u.pm * 256 + wr * 64 + fr; const float* mb = modv + (size_t)(u.pm >> 3) * NMODW;
        const int colb = u.pn * 256 + wc * 32 + 8 * fq;
        f32x4 mv[2][2];
#pragma unroll
        for (int bj = 0; bj < 2; ++bj)
#pragma unroll
            for (int n = 0; n < 2; ++n) mv[bj][n] = *(const f32x4*)(mb + colb + bj * 128 + 4 * n) * gs;
#pragma unroll
        for (int ai = 0; ai < 2; ++ai)
#pragma unroll
            for (int m = 0; m < 4; ++m) { const size_t o = (size_t)(row0 + ai * 128 + m * 16) * DM + colb;
                const f32x4 s00 = *(const f32x4*)(src + o), s01 = *(const f32x4*)(src + o + 4), s10 = *(const f32x4*)(src + o + 128), s11 = *(const f32x4*)(src + o + 132);
                *(f32x4*)(dst + o) = s00 + mv[0][0] * acc[ai][0][m][0]; *(f32x4*)(dst + o + 4) = s01 + mv[0][1] * acc[ai][0][m][1];
                *(f32x4*)(dst + o + 128) = s10 + mv[1][0] * acc[ai][1][m][0]; *(f32x4*)(dst + o + 132) = s11 + mv[1][1] * acc[ai][1][m][1]; }
    } };
struct EpiProj { static constexpr bool PERM = true, AFTER_DRAIN = false; unsigned char* ws;
    DI bool zero_after(const Unit&) const { return true; }
    DI void operator()(const f32x4 (&acc)[2][2][4][2], const Unit& u, int wr, int wc, int fr, int fq) const {
        asm volatile("" : "+v"(fr), "+v"(fq));
        const int pn = u.pn, row0 = u.pm * 256 + wr * 64 + fr;
        if (pn == 29) { float* dab = (float*)(ws + OFF_DAB);
            if (wc == 0 && fq < 2) {
#pragma unroll
                for (int ai = 0; ai < 2; ++ai)
#pragma unroll
                    for (int m = 0; m < 4; ++m)
#pragma unroll
                        for (int n = 0; n < 2; ++n) *(f32x4*)(dab + (size_t)(row0 + ai * 128 + m * 16) * 16 + 8 * fq + 4 * n) = acc[ai][0][m][n]; }
            return; }
        bf16_t* base; int ld, c0, act = 0;
        if (pn < 3) { base = (bf16_t*)(ws + OFF_AQKV); ld = 768; c0 = pn * 256; }
        else if (pn < 9) { base = (bf16_t*)(ws + OFF_DQKV); ld = 1536; c0 = (pn - 3) * 256; }
        else if (pn < 11) { base = (bf16_t*)(ws + OFF_DZ); ld = 512; c0 = (pn - 9) * 256; act = 1; }
        else if (pn < 17) { base = (bf16_t*)(ws + OFF_R); ld = 1536; c0 = (pn - 11) * 256; act = (pn >= 15) ? 1 : 0; }
        else { base = (bf16_t*)(ws + OFF_GATES); ld = 3072; c0 = (pn - 17) * 256; act = 2; }
        const int col0 = c0 + wc * 32 + 8 * fq;
#pragma unroll
        for (int ai = 0; ai < 2; ++ai)
#pragma unroll
            for (int m = 0; m < 4; ++m) { bf16_t* rowp = base + (size_t)(row0 + ai * 128 + m * 16) * ld + col0;
#pragma unroll
                for (int bj = 0; bj < 2; ++bj) { f32x4 v0 = acc[ai][bj][m][0], v1 = acc[ai][bj][m][1];
                    if (pn == 11 || pn == 12) {
                        const int row = row0 + ai * 128 + m * 16, cit = bj * 128 + wc * 32 + 8 * fq, hh = cit >> 6, d0 = cit & 63, pos = row & (SEQL - 1), ii = row & 63;
                        const float* tr = (const float*)(ws + OFF_TR) + ((size_t)pos * 32 + (d0 >> 1)) * 2; const f32x4 t0 = *(const f32x4*)tr, t1 = *(const f32x4*)(tr + 4);
                        const float lgh = logf(1.f - exp2f(-5.f - (float)hh)), sc = (pn == 11) ? expf(lgh * (float)(ii + 1)) : 0.125f * expf(lgh * (float)(63 - ii));
                        const f32x4 a = v0, bq = v1;
                        v0[0] = (a[0] * t0[0] - a[1] * t0[1]) * sc; v0[1] = (a[1] * t0[0] + a[0] * t0[1]) * sc; v0[2] = (a[2] * t0[2] - a[3] * t0[3]) * sc; v0[3] = (a[3] * t0[2] + a[2] * t0[3]) * sc;
                        v1[0] = (bq[0] * t1[0] - bq[1] * t1[1]) * sc; v1[1] = (bq[1] * t1[0] + bq[0] * t1[1]) * sc; v1[2] = (bq[2] * t1[2] - bq[3] * t1[3]) * sc; v1[3] = (bq[3] * t1[2] + bq[2] * t1[3]) * sc; }
                    if (act == 1) { for (int e = 0; e < 4; ++e) { v0[e] = silu_f(v0[e]); v1[e] = silu_f(v1[e]); } }
                    else if (act == 2) { for (int e = 0; e < 4; ++e) { v0[e] = sigm_f(v0[e]); v1[e] = sigm_f(v1[e]); } }
                    *(u32x4*)(rowp + bj * 128) = __builtin_bit_cast(u32x4, pack8(v0, v1)); } }
    } };
struct EpiMerge { static constexpr bool PERM = true, AFTER_DRAIN = false; const bf16_t* gates; bf16_t* merged;
    DI bool zero_after(const Unit& u) const { return (u.pn >> 2) == 2; }
    DI void operator()(f32x4 (&acc)[2][2][4][2], const Unit& u, int wr, int wc, int fr, int fq) const {
        asm volatile("" : "+v"(fr), "+v"(fq));
        const int b = u.pn >> 2, pm = u.pm & 63, pn = u.pn & 3, row0 = pm * 256 + wr * 64 + fr;
#pragma unroll
        for (int ai = 0; ai < 2; ++ai)
#pragma unroll
            for (int bj = 0; bj < 2; ++bj) { const int col0 = pn * 256 + bj * 128 + wc * 32 + 8 * fq;
                u32x4 gr[4], gnr[4];
#pragma unroll
                for (int m = 0; m < 4; ++m) { const size_t row = (size_t)(row0 + ai * 128 + m * 16); gr[m] = *(const u32x4*)(gates + row * 3072 + b * 1024 + col0);
                    gnr[m] = (b < 2) ? *(const u32x4*)(gates + row * 3072 + (b + 1) * 1024 + col0) : gr[m]; }
#pragma unroll
                for (int m = 0; m < 4; ++m) { const size_t row = (size_t)(row0 + ai * 128 + m * 16);
                    float g[8]; unpack8(gr[m], g);
                    f32x4& v0 = acc[ai][bj][m][0]; f32x4& v1 = acc[ai][bj][m][1];
                    if (b < 2) { float gn[8]; unpack8(gnr[m], gn);
#pragma unroll
                        for (int e = 0; e < 4; ++e) { v0[e] *= fmaxf(g[e], 1e-20f) * __builtin_amdgcn_rcpf(fmaxf(gn[e], 1e-20f)); v1[e] *= fmaxf(g[4 + e], 1e-20f) * __builtin_amdgcn_rcpf(fmaxf(gn[4 + e], 1e-20f)); } }
                    else { u32x4 w; w.x = pk2(v0[0] * fmaxf(g[0], 1e-20f), v0[1] * fmaxf(g[1], 1e-20f)); w.y = pk2(v0[2] * fmaxf(g[2], 1e-20f), v0[3] * fmaxf(g[3], 1e-20f));
                        w.z = pk2(v1[0] * fmaxf(g[4], 1e-20f), v1[1] * fmaxf(g[5], 1e-20f)); w.w = pk2(v1[2] * fmaxf(g[6], 1e-20f), v1[3] * fmaxf(g[7], 1e-20f));
                        *(u32x4*)(merged + row * DM + col0) = w; } } }
    } };
struct MergeOrder { int G, c;
    DI bool next(int i, Unit& u) const { const int T = c + G * (i / 3), b = i % 3; if (T >= 256) return false; u.pm = b * 64 + (T >> 2); u.pn = b * 4 + (T & 3); return true; }
    DI void a_ready(const Unit&) const {} DI void done(const Unit&) const {} };

DI float wave_sum(float v) {
#pragma unroll
    for (int o = 1; o < 64; o <<= 1) v += __shfl_xor(v, o);
    return v; }

DI void phase_mod(const Params& p, unsigned char* lds, int tid) {
    float* sc = (float*)lds; float* red = sc + 8192;
    const float* c = p.in[1]; float* MOD = (float*)(p.ws + OFF_MOD);
    for (int i = tid; i < 8192; i += 512) { const float v = c[i]; sc[i] = v / (1.f + expf(-v)); }
    __syncthreads();
    for (int grp = blockIdx.x; grp < 256; grp += gridDim.x) {
        const int cc = tid % 72, kp = tid / 72;
        const int n = grp * 72 + cc, l = n / NMODW, nn = n % NMODW;
        float a0 = 0, a1 = 0, a2 = 0, a3 = 0, a4 = 0, a5 = 0, a6 = 0, a7 = 0;
        if (kp < 7) {
            const float* w = p.in[2] + (size_t)l * DM * NMODW + nn;
            for (int kb = kp * 147; kb < kp * 147 + 147; kb += 21) {
                float wv[21];
#pragma unroll
                for (int q = 0; q < 21; ++q) { const int k = kb + q; wv[q] = (k < DM) ? w[(size_t)k * NMODW] : 0.f; }
#pragma unroll
                for (int q = 0; q < 21; ++q) { const int k = (kb + q < DM) ? kb + q : 0; const float x = wv[q];
                    a0 += sc[k] * x; a1 += sc[1024 + k] * x; a2 += sc[2048 + k] * x; a3 += sc[3072 + k] * x; a4 += sc[4096 + k] * x; a5 += sc[5120 + k] * x; a6 += sc[6144 + k] * x; a7 += sc[7168 + k] * x; }
            }
            red[(kp * 8 + 0) * 72 + cc] = a0; red[(kp * 8 + 1) * 72 + cc] = a1; red[(kp * 8 + 2) * 72 + cc] = a2; red[(kp * 8 + 3) * 72 + cc] = a3;
            red[(kp * 8 + 4) * 72 + cc] = a4; red[(kp * 8 + 5) * 72 + cc] = a5; red[(kp * 8 + 6) * 72 + cc] = a6; red[(kp * 8 + 7) * 72 + cc] = a7;
        }
        __syncthreads();
        for (int o = tid; o < 8 * 72; o += 512) { const int b = o / 72, c2 = o % 72; float s = 0.f;
#pragma unroll
            for (int q = 0; q < 7; ++q) s += red[(q * 8 + b) * 72 + c2];
            const int n2 = grp * 72 + c2, l2 = n2 / NMODW, nn2 = n2 % NMODW;
            MOD[(size_t)(l2 * 8 + b) * NMODW + nn2] = s + p.in[3][l2 * NMODW + nn2]; }
        __syncthreads();
    }
    const int gt = blockIdx.x * 512 + tid, NT = gridDim.x * 512;
    float* TA = (float*)(p.ws + OFF_TA); float* TR = (float*)(p.ws + OFF_TR);
    for (int idx = gt; idx < 2048 * 8; idx += NT) { const int pos = idx >> 3, pp = idx & 7;
        const float invf = exp2f(-18.931568569324174f * ((float)(2 * pp) * (1.f / 16.f))); float rev = (float)pos * invf * 0.15915494309189535f; rev -= rintf(rev);
        TA[idx * 2] = __builtin_amdgcn_cosf(rev); TA[idx * 2 + 1] = __builtin_amdgcn_sinf(rev); }
    for (int idx = gt; idx < 2048 * 32; idx += NT) { const int pos = idx >> 5, pp = idx & 31;
        const float ang = exp2f(-13.287712379549449f * ((float)pp * (1.f / 31.f))); float rev = (float)pos * ang * 0.15915494309189535f; rev -= rintf(rev);
        TR[idx * 2] = __builtin_amdgcn_cosf(rev); TR[idx * 2 + 1] = __builtin_amdgcn_sinf(rev); }
}

DI int dstrow(int mode, int n) {
    if (mode == 1) return (n < DFF) ? ((n >> 7) * 256 + (n & 127)) : (((n - DFF) >> 7) * 256 + 128 + ((n - DFF) & 127));
    if (mode == 2) return (n < 2304) ? n : ((n < 2320) ? (7424 + n - 2304) : (n - 16));
    return n; }
DI void conv_item(const float* W, int K, int N, bf16_t* WT, int mode, float* scr, int item, int lane) {
    const int nblk = (N + 31) / 32, kb = item / nblk, nb = item % nblk, k0 = 64 * kb, n0 = 32 * nb;
    const int nn = n0 + (lane & 31); const bool okn = nn < N;
    float wv[32];
#pragma unroll
    for (int i = 0; i < 32; ++i) { const int kk = 2 * i + (lane >> 5); wv[i] = okn ? W[(size_t)(k0 + kk) * N + nn] : 0.f; }
#pragma unroll
    for (int i = 0; i < 32; ++i) { const int kk = 2 * i + (lane >> 5); scr[kk * 33 + (lane & 31)] = wv[i]; }
    asm volatile("s_waitcnt lgkmcnt(0)" ::: "memory");
    const int c = lane & 7;
#pragma unroll
    for (int j = 0; j < 4; ++j) { const int n = (lane >> 3) + 8 * j; const float* s = scr + (8 * c) * 33 + n;
        u32x4 o; o.x = pk2(s[0 * 33], s[1 * 33]); o.y = pk2(s[2 * 33], s[3 * 33]); o.z = pk2(s[4 * 33], s[5 * 33]); o.w = pk2(s[6 * 33], s[7 * 33]);
        if (n0 + n < N) *(u32x4*)(WT + (size_t)dstrow(mode, n0 + n) * K + k0 + 8 * c) = o; }
    asm volatile("s_waitcnt lgkmcnt(0)" ::: "memory");
}
DI void modulate_rows(const float* x, const float* gain, const float* modl, int slot, bf16_t* U, int gw, int NGW, int lane) {
    constexpr int NR = 4;
    for (int m0 = gw; m0 < MT; m0 += NR * NGW) {
        int mr[NR]; f32x4 v[NR][4]; float s[NR];
#pragma unroll
        for (int q = 0; q < NR; ++q) { mr[q] = (m0 + q * NGW < MT) ? m0 + q * NGW : m0;
#pragma unroll
            for (int j = 0; j < 4; ++j) v[q][j] = ((const f32x4*)(x + (size_t)mr[q] * DM) + lane)[64 * j]; }
#pragma unroll
        for (int q = 0; q < NR; ++q) { float a = 0.f;
#pragma unroll
            for (int j = 0; j < 4; ++j) a += (v[q][j][0] * v[q][j][0] + v[q][j][1] * v[q][j][1]) + (v[q][j][2] * v[q][j][2] + v[q][j][3] * v[q][j][3]);
            s[q] = rsqrtf(wave_sum(a) * (1.f / DM) + EPSF); }
#pragma unroll
        for (int j = 0; j < 4; ++j) { const int d = 4 * lane + 256 * j; const f32x4 g = *(const f32x4*)(gain + d);
#pragma unroll
            for (int q = 0; q < NR; ++q) { const float* mb = modl + (size_t)(mr[q] >> 11) * NMODW + slot * 3 * DM;
                const f32x4 y = v[q][j] * s[q] * g * (*(const f32x4*)(mb + DM + d) + 1.f) + *(const f32x4*)(mb + d);
                ((unsigned long long*)(U + (size_t)mr[q] * DM) + lane)[64 * j] = (unsigned long long)pk2(y[0], y[1]) | ((unsigned long long)pk2(y[2], y[3]) << 32); } }
    }
}
DI void convert_ffn(const Params& p, int l, int which  , unsigned char* lds, int tid, int gw, int NGW) {
    const int lane = tid & 63, wave = tid >> 6; float* scr = (float*)(lds + wave * 16384);
    const float* w13 = p.in[which == 0 ? 5 : 19] + (size_t)l * DM * 2 * DFF; const float* w2 = p.in[which == 0 ? 6 : 20] + (size_t)l * DFF * DM;
    constexpr int I13 = 16 * 176, I2 = 44 * 32;
    for (int it = gw; it < I13 + I2; it += NGW) {
        if (it < I13) conv_item(w13, DM, 2 * DFF, (bf16_t*)(p.ws + OFF_W13T), 1, scr, it, lane);
        else conv_item(w2, DFF, DM, (bf16_t*)(p.ws + OFF_W2T), 0, scr, it - I13, lane); }
}
DI void convert_mix(const Params& p, int l, unsigned char* lds, int tid, int gw, int NGW) {
    unsigned zu = 0u; asm volatile("" : "+v"(zu));
    const int lane = tid & 63, wave = tid >> 6; float* scr = (float*)(lds + wave * 16384);
    const float* win = p.in[8] + (size_t)l * DM * 7440; const float* wb = p.in[16] + (size_t)l * 3 * 512 * DM; const float* wo = p.in[17] + (size_t)l * DM * DM;
    constexpr int IIN = 16 * 233, IB = 8 * 32, IO = 16 * 32;
    for (int it = gw; it < IIN + 3 * IB + IO; it += NGW) { int r = it;
        if (r < IIN) { conv_item(win, DM, 7440, (bf16_t*)(p.ws + OFF_WINT), 2, scr, r, lane); continue; } r -= IIN;
        if (r < 3 * IB) { const int g = r / IB; conv_item(wb + (size_t)g * 512 * DM, 512, DM, (bf16_t*)(p.ws + OFF_WBT) + (size_t)g * DM * 512, 0, scr, r % IB, lane); continue; } r -= 3 * IB;
        conv_item(wo, DM, DM, (bf16_t*)(p.ws + OFF_WOT), 0, scr, r, lane); }
    u32x4* z = (u32x4*)(p.ws + OFF_WINT + (size_t)7440 * DM * 2);
    for (int i = gw * 64 + lane; i < 240 * DM * 2 / 16; i += NGW * 64) z[i] = (u32x4){zu, zu, zu, zu};
}
DI void phase_prep(const Params& p, int l, int which  , const float* xsrc, unsigned char* lds, int tid) {
    const int lane = tid & 63, wave = tid >> 6, gw = blockIdx.x * 8 + wave, NGW = gridDim.x * 8;
    const float* gain = p.in[which == 0 ? 4 : (which == 1 ? 7 : 18)] + l * DM;
    modulate_rows(xsrc, gain, (const float*)(p.ws + OFF_MOD) + (size_t)l * 8 * NMODW, which, (bf16_t*)(p.ws + OFF_U), gw, NGW, lane);
    if (which == 1) convert_mix(p, l, lds, tid, gw, NGW); else convert_ffn(p, l, which, lds, tid, gw, NGW);
}
constexpr int PREP_CHUNK_BYTES = 40960;
DI void dn_prep_fetch(const Params& p, int item, int tid, u32x4 (&pre)[12]) {
    const int h = item & 7, n = (item >> 3) & 31, b = item >> 8, i = tid >> 3, d0 = (tid & 7) * 8;
    const bf16_t* DQKV = (const bf16_t*)(p.ws + OFF_DQKV);
#pragma unroll
    for (int mat = 0; mat < 3; ++mat)
#pragma unroll
        for (int j = 0; j < 4; ++j) { int t = n * 64 + i - 3 + j; t = t < 0 ? 0 : t; pre[mat * 4 + j] = *(const u32x4*)(DQKV + (size_t)(b * SEQL + t) * 1536 + mat * 512 + h * 64 + d0); }
}
DI void dn_prep_item(const Params& p, int l, int item, int next_item, u32x4 (&pre)[12], unsigned char* lds, int tid) {
    float zz = 0.f; asm volatile("" : "+v"(zz));
    const int h = item & 7, n = (item >> 3) & 31, b = item >> 8, lane = tid & 63;
    float* Qs = (float*)lds; float* Ks = Qs + 4160; float* Vs = Ks + 4160; float* Ls = Vs + 4160; float* AIs = Ls + 4096; float* XS = AIs + 4096;
    float* Gs = XS + 64 * 129; float* BETAs = Gs + 64; float* EGs = BETAs + 64;
    bf16_t* KH = (bf16_t*)(EGs + 64); bf16_t* KL = KH + 64 * 72; bf16_t* QH = KL + 64 * 72; bf16_t* QL = QH + 64 * 72;
    const float* DAB = (const float*)(p.ws + OFF_DAB);
    const float* cw = p.in[12] + (size_t)l * 4 * 1536;
    float da_raw = 0.f, db_raw = 0.f, dtb = 0.f, alog = 0.f;
    if (tid < 64) { const size_t tok = (size_t)b * SEQL + n * 64 + tid; da_raw = DAB[tok * 16 + h]; db_raw = DAB[tok * 16 + 8 + h]; dtb = p.in[14][l * 8 + h]; alog = p.in[13][l * 8 + h]; }
    {
        const int i = tid >> 3, d0 = (tid & 7) * 8;
#pragma unroll
        for (int mat = 0; mat < 3; ++mat) { const int col = mat * 512 + h * 64 + d0; float a[8];
#pragma unroll
            for (int e = 0; e < 8; ++e) a[e] = 0.f;
#pragma unroll
            for (int j = 0; j < 4; ++j) { const int t = n * 64 + i - 3 + j;
                if (t >= 0) { float xv[8]; unpack8(pre[mat * 4 + j], xv);
                    const f32x4 w0 = *(const f32x4*)(cw + j * 1536 + col), w1 = *(const f32x4*)(cw + j * 1536 + col + 4);
#pragma unroll
                    for (int e = 0; e < 4; ++e) { a[e] += w0[e] * xv[e]; a[4 + e] += w1[e] * xv[4 + e]; } } }
            float ss = 0.f;
#pragma unroll
            for (int e = 0; e < 8; ++e) { a[e] = silu_f(a[e]); ss += a[e] * a[e]; }
            float sc = 1.f;
            if (mat < 2) { ss += __shfl_xor(ss, 1); ss += __shfl_xor(ss, 2); ss += __shfl_xor(ss, 4); sc = rsqrtf(ss + EPSF) * (mat == 0 ? 0.125f : 1.f); }
            float* dst = (mat == 0 ? Qs : (mat == 1 ? Ks : Vs)) + i * 65 + d0;
#pragma unroll
            for (int e = 0; e < 8; ++e) { a[e] *= sc; dst[e] = a[e]; }
            if (mat < 2) { float hf[8], lo[8]; u32x4 wh, wl;
                wh.x = pk2(a[0], a[1]); wh.y = pk2(a[2], a[3]); wh.z = pk2(a[4], a[5]); wh.w = pk2(a[6], a[7]); unpack8(wh, hf);
#pragma unroll
                for (int e = 0; e < 8; ++e) lo[e] = a[e] - hf[e];
                wl.x = pk2(lo[0], lo[1]); wl.y = pk2(lo[2], lo[3]); wl.z = pk2(lo[4], lo[5]); wl.w = pk2(lo[6], lo[7]);
                *(u32x4*)((mat == 0 ? QH : KH) + i * 72 + d0) = wh; *(u32x4*)((mat == 0 ? QL : KL) + i * 72 + d0) = wl; } }
        { f32x4* z = (f32x4*)AIs + tid * 2; z[0] = (f32x4){zz, zz, zz, zz}; z[1] = (f32x4){zz, zz, zz, zz}; }
    }
    if (tid < 64) {
        const float a = da_raw + dtb, bb = db_raw;
        const float sp = (a > 20.f) ? a : ((a < -15.f) ? expf(a) : logf(1.f + expf(a)));
        float x = -expf(alog) * sp;
#pragma unroll
        for (int o = 1; o < 64; o <<= 1) { const float v = __shfl_up(x, o); if (lane >= o) x += v; }
        Gs[tid] = x; BETAs[tid] = 1.f / (1.f + expf(-bb)); EGs[tid] = expf(x);
    }
    __syncthreads();
    {
        const int wv = tid >> 6, c = lane & 15, g = lane >> 4;
        for (int t = wv; t < 20; t += 8) { const int isq = t >= 10, tt = isq ? t - 10 : t, it = (tt >= 6) ? 3 : ((tt >= 3) ? 2 : ((tt >= 1) ? 1 : 0)), jt = tt - it * (it + 1) / 2;
            const bf16_t* XHp = (isq ? QH : KH) + (16 * it + c) * 72 + 8 * g; const bf16_t* XLp = (isq ? QL : KL) + (16 * it + c) * 72 + 8 * g;
            const bf16_t* KHp = KH + (16 * jt + c) * 72 + 8 * g; const bf16_t* KLp = KL + (16 * jt + c) * 72 + 8 * g;
            f32x4 acc = (f32x4){zz, zz, zz, zz};
#pragma unroll
            for (int s = 0; s < 2; ++s) { const bf16x8 xh = *(const bf16x8*)(XHp + 32 * s), xl = *(const bf16x8*)(XLp + 32 * s), kh = *(const bf16x8*)(KHp + 32 * s), kl = *(const bf16x8*)(KLp + 32 * s);
                acc = MFMA16(xl, kh, acc); acc = MFMA16(xh, kl, acc); acc = MFMA16(xh, kh, acc); }
            const int jj = 16 * jt + c; const float gj = Gs[jj];
#pragma unroll
            for (int rr = 0; rr < 4; ++rr) { const int ii = 16 * it + 4 * g + rr; const float dec = (jj <= ii) ? expf(Gs[ii] - gj) : 0.f;
                if (isq) AIs[ii * 64 + jj] = (jj <= ii) ? acc[rr] * dec : 0.f; else Ls[ii * 64 + jj] = (jj < ii) ? BETAs[ii] * acc[rr] * dec : 0.f; } }
    }
    __syncthreads();
    {
        const int wv = tid >> 6; float* Zs = (float*)(QL + 64 * 72);
        if (wv < 5) {
            const int half = (wv >= 2) ? 1 : 0, c = (wv < 2) ? tid : ((wv < 4) ? tid - 128 : (lane & 31)), r0 = 32 * half;
            const float* Lb = Ls + r0 * 64 + r0;
            float x[32];
            if (wv < 4) {
#pragma unroll
                for (int i = 0; i < 32; ++i) x[i] = (c < 64) ? BETAs[r0 + i] * Vs[(r0 + i) * 65 + c] : BETAs[r0 + i] * Ks[(r0 + i) * 65 + c - 64] * EGs[r0 + i];
            } else {
#pragma unroll
                for (int i = 0; i < 32; ++i) x[i] = Ls[(32 + i) * 64 + c];
            }
            f32x4 cur[8], nxt[8];
            cur[0] = *(const f32x4*)(Lb + 64);
#pragma unroll
            for (int i = 1; i < 32; ++i) {
                if (i < 31) {
#pragma unroll
                    for (int q = 0; q < 8; ++q) if (4 * q < i + 1) nxt[q] = *(const f32x4*)(Lb + (i + 1) * 64 + 4 * q);
                }
                float a0 = x[i], a1 = 0.f, a2 = 0.f, a3 = 0.f;
#pragma unroll
                for (int j = 0; j < i; ++j) { const float lv = cur[j >> 2][j & 3];
                    if ((j & 3) == 0) a0 -= lv * x[j]; else if ((j & 3) == 1) a1 -= lv * x[j]; else if ((j & 3) == 2) a2 -= lv * x[j]; else a3 -= lv * x[j]; }
                x[i] = (a0 + a1) + (a2 + a3);
#pragma unroll
                for (int q = 0; q < 8; ++q) cur[q] = nxt[q];
            }
            if (wv < 4) {
#pragma unroll
                for (int i = 0; i < 32; ++i) XS[(r0 + i) * 129 + c] = x[i];
            } else if (lane < 32) {
#pragma unroll
                for (int i = 0; i < 32; ++i) Zs[i * 33 + c] = x[i];
            }
        } else {
            const int chunk_ = (b * 8 + h) * 32 + n; unsigned char* base_ = p.ws + OFF_U + (size_t)chunk_ * PREP_CHUNK_BYTES;
            const int r = lane & 15, g = lane >> 4; const float g63 = Gs[63];
            for (int q = wv - 5; q < 24; q += 3) { const int mat = q >> 3, f = q & 7, m = f >> 1, s = f & 1, row = 16 * m + r, c0 = 32 * s + 4 * g, c1 = c0 + 16;
                float v[8];
                if (mat == 0) { const float eg = EGs[row]; const float* a = Qs + row * 65;
#pragma unroll
                    for (int e = 0; e < 4; ++e) { v[e] = a[c0 + e] * eg; v[4 + e] = a[c1 + e] * eg; } }
                else if (mat == 1) { const float* a = AIs + row * 64;
#pragma unroll
                    for (int e = 0; e < 4; ++e) { v[e] = a[c0 + e]; v[4 + e] = a[c1 + e]; } }
                else {
#pragma unroll
                    for (int e = 0; e < 4; ++e) { v[e] = Ks[(c0 + e) * 65 + row] * expf(g63 - Gs[c0 + e]); v[4 + e] = Ks[(c1 + e) * 65 + row] * expf(g63 - Gs[c1 + e]); } }
                u32x4 w; w.x = pk2(v[0], v[1]); w.y = pk2(v[2], v[3]); w.z = pk2(v[4], v[5]); w.w = pk2(v[6], v[7]);
                *(u32x4*)(base_ + 8192 * (mat + 1) + (size_t)(f * 64 + lane) * 16) = w; }
        }
        __syncthreads();
        {
            const int c = tid & 127, rg = tid >> 7;
            float xt[32];
#pragma unroll
            for (int k = 0; k < 32; ++k) xt[k] = XS[k * 129 + c];
#pragma unroll
            for (int ii = 0; ii < 8; ++ii) { const int i = rg * 8 + ii; float a0 = XS[(32 + i) * 129 + c], a1 = 0.f;
#pragma unroll
                for (int k = 0; k < 32; k += 2) { a0 -= Zs[i * 33 + k] * xt[k]; a1 -= Zs[i * 33 + k + 1] * xt[k + 1]; }
                XS[(32 + i) * 129 + c] = a0 + a1; }
        }
    }
    __syncthreads();
    dn_prep_fetch(p, next_item < 2048 ? next_item : item, tid, pre);
    {
        const int chunk = (b * 8 + h) * 32 + n; unsigned char* base = p.ws + OFF_U + (size_t)chunk * PREP_CHUNK_BYTES;
        const int f = tid >> 6, m = f >> 1, s = f & 1, r = lane & 15, g = lane >> 4, row = 16 * m + r, c0 = 32 * s + 4 * g, c1 = c0 + 16;
        u32x4 w;
        { const float* a = XS + row * 129 + 64; w.x = pk2(a[c0], a[c0 + 1]); w.y = pk2(a[c0 + 2], a[c0 + 3]); w.z = pk2(a[c1], a[c1 + 1]); w.w = pk2(a[c1 + 2], a[c1 + 3]); *(u32x4*)(base + (size_t)tid * 16) = w; }
#pragma unroll
        for (int q = 0; q < 2; ++q) { const int idx = tid * 2 + q, wm = idx >> 6, ln = idx & 63, vv = 16 * (wm >> 2) + (ln & 15), r0 = 16 * (wm & 3) + 4 * (ln >> 4);
            u32x2 o; o.x = pk2(XS[r0 * 129 + vv], XS[(r0 + 1) * 129 + vv]); o.y = pk2(XS[(r0 + 2) * 129 + vv], XS[(r0 + 3) * 129 + vv]); *(u32x2*)(base + 32768 + (size_t)idx * 8) = o; }
        if (tid == 0) ((float*)(p.ws + OFF_CD))[chunk] = EGs[63];
    }
    __syncthreads();
}

DI void dn_scan_wg(const Params& p, int l, int bh, unsigned char* lds, int tid) {
    float zz = 0.f; unsigned zu = 0u; asm volatile("" : "+v"(zz), "+v"(zu));
    const int lane = tid & 63, w = tid >> 6, b = bh >> 3, h = bh & 7, c = lane & 15, g = lane >> 4;
    unsigned char* OX = lds + 2 * PREP_CHUNK_BYTES;
    const bf16_t* DZ = (const bf16_t*)(p.ws + OFF_DZ); bf16_t* BRB = (bf16_t*)(p.ws + OFF_DQKV) + (size_t)MT * 512;
    const unsigned char* gsrc = p.ws + OFF_U + (size_t)(bh * 32) * PREP_CHUNK_BYTES;
    const float* CDp = (const float*)(p.ws + OFF_CD) + bh * 32;
    {
        u32x4 t0[5];
#pragma unroll
        for (int k = 0; k < 5; ++k) t0[k] = *(const u32x4*)(gsrc + (size_t)tid * 16 + k * 8192);
#pragma unroll
        for (int k = 0; k < 5; ++k) *(u32x4*)(lds + tid * 16 + k * 8192) = t0[k];
    }
    const int st = (w & 3) * 64 + lane;
    u32x4 stA[10], stB[10]; bf16_t gzA[4][4], gzB[4][4]; float onv[4];
    f32x4 S[4];
#pragma unroll
    for (int i = 0; i < 4; ++i) S[i] = (f32x4){zz, zz, zz, zz};
    if (w >= 4) {
#pragma unroll
        for (int k = 0; k < 10; ++k) { stA[k] = *(const u32x4*)(gsrc + (size_t)PREP_CHUNK_BYTES + (size_t)st * 16 + k * 4096); stB[k] = stA[k]; }
#pragma unroll
        for (int q = 0; q < 4; ++q) onv[q] = p.in[15][l * 64 + 16 * q + c];
#pragma unroll
        for (int q = 0; q < 4; ++q)
#pragma unroll
            for (int r = 0; r < 4; ++r) { gzA[q][r] = 0; gzB[q][r] = 0; }
    }
    __syncthreads();
#define DN_FINAL(nn, GZ) do { const unsigned char* ox = OX + ((nn) & 1) * 16384; const int x = w - 4; f32x4 o[4]; float q0 = 0.f, q1 = 0.f, q2 = 0.f, q3 = 0.f; \
        _Pragma("unroll") for (int q = 0; q < 4; ++q) { o[q] = *(const f32x4*)(ox + ((q * 4 + x) * 64 + lane) * 16); q0 += o[q][0] * o[q][0]; q1 += o[q][1] * o[q][1]; q2 += o[q][2] * o[q][2]; q3 += o[q][3] * o[q][3]; } \
        ROW_SUM16(q0); ROW_SUM16(q1); ROW_SUM16(q2); ROW_SUM16(q3); \
        const float rs[4] = {rsqrtf(q0 * (1.f / 64.f) + EPSF), rsqrtf(q1 * (1.f / 64.f) + EPSF), rsqrtf(q2 * (1.f / 64.f) + EPSF), rsqrtf(q3 * (1.f / 64.f) + EPSF)}; \
        _Pragma("unroll") for (int q = 0; q < 4; ++q) _Pragma("unroll") for (int r = 0; r < 4; ++r) { \
            const size_t tok = (size_t)b * SEQL + (nn) * 64 + 16 * x + 4 * g + r; \
            BRB[tok * 512 + h * 64 + 16 * q + c] = (bf16_t)f2bf(o[q][r] * rs[r] * onv[q] * bf1(GZ[q][r])); } } while (0)
#define DN_STEP(n, X, Y, GZC, GZN) do { \
        if (w < 4) { \
            const unsigned char* buf = lds + ((n) & 1) * PREP_CHUNK_BYTES; \
            const float cd = CDp[(n)]; \
            bf16x8 Sb[2]; Sb[0] = pack8(S[0], S[1]); Sb[1] = pack8(S[2], S[3]); \
            f32x4 vn[4]; \
            _Pragma("unroll") for (int m = 0; m < 4; ++m) { f32x4 t = (f32x4){zz, zz, zz, zz}; \
                t = MFMA16(*(const bf16x8*)(buf + ((m * 2 + 0) * 64 + lane) * 16), Sb[0], t); t = MFMA16(*(const bf16x8*)(buf + ((m * 2 + 1) * 64 + lane) * 16), Sb[1], t); \
                const u32x2 uu = *(const u32x2*)(buf + 32768 + ((w * 4 + m) * 64 + lane) * 8); \
                vn[m] = (f32x4){bflo(uu.x), bfhi(uu.x), bflo(uu.y), bfhi(uu.y)} - t; } \
            bf16x8 vb[2]; vb[0] = pack8(vn[0], vn[1]); vb[1] = pack8(vn[2], vn[3]); \
            _Pragma("unroll") for (int kt = 0; kt < 4; ++kt) { f32x4 t = S[kt] * cd; \
                t = MFMA16(*(const bf16x8*)(buf + 24576 + ((kt * 2 + 0) * 64 + lane) * 16), vb[0], t); t = MFMA16(*(const bf16x8*)(buf + 24576 + ((kt * 2 + 1) * 64 + lane) * 16), vb[1], t); S[kt] = t; } \
            _Pragma("unroll") for (int m = 0; m < 4; ++m) { f32x4 t = (f32x4){zz, zz, zz, zz}; \
                t = MFMA16(*(const bf16x8*)(buf + 8192 + ((m * 2 + 0) * 64 + lane) * 16), Sb[0], t); t = MFMA16(*(const bf16x8*)(buf + 8192 + ((m * 2 + 1) * 64 + lane) * 16), Sb[1], t); \
                t = MFMA16(*(const bf16x8*)(buf + 16384 + ((m * 2 + 0) * 64 + lane) * 16), vb[0], t); t = MFMA16(*(const bf16x8*)(buf + 16384 + ((m * 2 + 1) * 64 + lane) * 16), vb[1], t); \
                *(f32x4*)(OX + ((n) & 1) * 16384 + ((w * 4 + m) * 64 + lane) * 16) = t; } \
        } else { \
            _Pragma("unroll") for (int q = 0; q < 4; ++q) _Pragma("unroll") for (int r = 0; r < 4; ++r) GZN[q][r] = DZ[((size_t)b * SEQL + (n) * 64 + 16 * (w - 4) + 4 * g + r) * 512 + h * 64 + 16 * q + c]; \
            if ((n) + 2 < 32) { _Pragma("unroll") for (int k = 0; k < 10; ++k) Y[k] = *(const u32x4*)(gsrc + (size_t)((n) + 2) * PREP_CHUNK_BYTES + (size_t)st * 16 + k * 4096); } \
            if ((n) >= 1) DN_FINAL((n) - 1, GZC); \
            if ((n) + 1 < 32) { _Pragma("unroll") for (int k = 0; k < 10; ++k) *(u32x4*)(lds + (((n) + 1) & 1) * PREP_CHUNK_BYTES + st * 16 + k * 4096) = X[k]; } \
        } \
        __syncthreads(); } while (0)
    for (int n = 0; n < 32; n += 2) { DN_STEP(n, stA, stB, gzB, gzA); DN_STEP(n + 1, stB, stA, gzA, gzB); }
    if (w >= 4) DN_FINAL(31, gzB);
#undef DN_STEP
#undef DN_FINAL
}

typedef short v4i16_t __attribute__((ext_vector_type(4)));
DI u32x2 trread(const bf16_t* p) { return __builtin_bit_cast(u32x2, __builtin_amdgcn_ds_read_tr16_b64_v4i16((__attribute__((address_space(3))) v4i16_t*)p)); }
DI void ret_scan_wg(const Params& p, int l, int bhi, unsigned char* lds, int tid) {
    const int bh = bhi >> 1, ih = bhi & 1;
    float zz = 0.f; unsigned zu = 0u; asm volatile("" : "+v"(zz), "+v"(zu));
    const int lane = tid & 63, w = tid >> 6, b = bh >> 2, h = bh & 3;
    constexpr int RB = 35840;
    float* red = (float*)(lds + 3 * RB);
    float* OT = (float*)(lds + 3 * RB + 4096);
    unsigned char* PA = lds + 3 * RB + 4096 + 33792;
    const int tokrow = tid >> 4, cp = tid & 15;
    const bf16_t* R = (const bf16_t*)(p.ws + OFF_R); bf16_t* BRC = (bf16_t*)(p.ws + OFF_DQKV) + (size_t)2 * MT * 512;
    const float lg = logf(1.f - exp2f(-5.f - (float)h)), cfac = expf(-64.f * lg), cdec = expf(64.f * lg);
    f32x4 S[4], out[2];
#pragma unroll
    for (int i = 0; i < 4; ++i) S[i] = (f32x4){zz, zz, zz, zz};
    out[0] = S[0]; out[1] = S[0];
    const int itA = ih ? 1 : 0, itB = ih ? 2 : 3;
    const int li = tid >> 3, ld0 = (tid & 7) * 8, lc0 = (tid & 7) * 16;
    const bf16_t* gsrc = R + ((size_t)b * SEQL + li) * 1536;
#define RET_LOAD(X, nn) do { const bf16_t* r_ = gsrc + (size_t)(nn) * 64 * 1536; X[0] = *(const u32x4*)(r_ + h * 64 + ld0); X[1] = *(const u32x4*)(r_ + 256 + h * 64 + ld0); \
        X[2] = *(const u32x4*)(r_ + 512 + h * 128 + lc0); X[3] = *(const u32x4*)(r_ + 512 + h * 128 + lc0 + 8); } while (0)
#define RET_STORE(X, bufi) do { bf16_t* B_ = (bf16_t*)(lds + (bufi) * RB); *(u32x4*)(B_ + li * 72 + ld0) = X[0]; *(u32x4*)(B_ + 64 * 72 + li * 72 + ld0) = X[1]; \
        *(u32x4*)(B_ + 128 * 72 + li * 136 + lc0) = X[2]; *(u32x4*)(B_ + 128 * 72 + li * 136 + lc0 + 8) = X[3]; } while (0)
    const int c_ = lane & 15, g_ = lane >> 4;
#define RET_PTILE(nn) do { const int e_ = w >> 2, jt_ = w & 3, it_ = e_ ? itB : itA; \
        const bf16_t* QDp = (const bf16_t*)(lds + ((nn) % 3) * RB); const bf16_t* KTp = QDp + 64 * 72; \
        f32x4 t = (f32x4){zz, zz, zz, zz}; \
        if (jt_ <= it_) { const bf16x8 q0 = *(const bf16x8*)(QDp + (16 * it_ + c_) * 72 + 8 * g_), q1 = *(const bf16x8*)(QDp + (16 * it_ + c_) * 72 + 32 + 8 * g_); \
            const bf16x8 k0 = *(const bf16x8*)(KTp + (16 * jt_ + c_) * 72 + 8 * g_), k1 = *(const bf16x8*)(KTp + (16 * jt_ + c_) * 72 + 32 + 8 * g_); \
            t = MFMA16(k0, q0, t); t = MFMA16(k1, q1, t); t = t * cfac; \
            if (jt_ == it_) { _Pragma("unroll") for (int r = 0; r < 4; ++r) t[r] = (4 * g_ + r <= c_) ? t[r] : 0.f; } } \
        u32x2 hv; hv.x = pk2(t[0], t[1]); hv.y = pk2(t[2], t[3]); \
        *(u32x2*)(PA + ((nn) & 1) * 4096 + ((e_ * 2 + (jt_ >> 1)) * 64 + lane) * 16 + (jt_ & 1) * 8) = hv; } while (0)
    u32x4 stA[4], stB[4];
    RET_LOAD(stA, 0); RET_LOAD(stB, 1); RET_STORE(stA, 0); RET_STORE(stB, 1); RET_LOAD(stA, 2);
    __syncthreads();
    RET_PTILE(0);
    __syncthreads();
#define RET_STEP(n, X, Y) do { \
        int c = c_, g = g_; asm volatile("" : "+v"(c), "+v"(g)); \
        const bf16_t* QD = (const bf16_t*)(lds + ((n) % 3) * RB); const bf16_t* KT = QD + 64 * 72; const bf16_t* VS = KT + 64 * 72; \
        const size_t tokp = (size_t)b * SEQL + ((n) - 1) * 64 + 16 * ((tokrow >> 4) ? itB : itA) + (tokrow & 15); \
        u32x4 gq = (u32x4){zu, zu, zu, zu}; if ((n) >= 1) gq = *(const u32x4*)(R + tokp * 1536 + 1024 + h * 128 + 8 * cp); \
        if ((n) + 3 < 32) RET_LOAD(Y, (n) + 3); \
        if ((n) + 1 < 32) RET_PTILE((n) + 1); \
        bf16x8 Vb[2], Sb[2]; \
        const int tq = c >> 2, tp = c & 3; \
        _Pragma("unroll") for (int s = 0; s < 2; ++s) { const bf16_t* vp = VS + (32 * s + 4 * g + tq) * 136 + 16 * w + 4 * tp; Vb[s] = cat8(trread(vp), trread(vp + 16 * 136)); } \
        Sb[0] = pack8(S[0], S[1]); Sb[1] = pack8(S[2], S[3]); \
        _Pragma("unroll") for (int e = 0; e < 2; ++e) { const int it = e ? itB : itA; \
            const unsigned char* pap = PA + ((n) & 1) * 4096 + (e * 2 * 64 + lane) * 16; \
            f32x4 o = (f32x4){zz, zz, zz, zz}; \
            o = MFMA16(*(const bf16x8*)pap, Vb[0], o); \
            if (it >= 2) o = MFMA16(*(const bf16x8*)(pap + 1024), Vb[1], o); \
            _Pragma("unroll") for (int s = 0; s < 2; ++s) { const bf16_t* qp = QD + (16 * it + c) * 72 + 32 * s + 4 * g; o = MFMA16(cat8(*(const u32x2*)qp, *(const u32x2*)(qp + 16)), Sb[s], o); } \
            out[e] = o; \
        } \
        _Pragma("unroll") for (int dt = 0; dt < 4; ++dt) { f32x4 t = S[dt] * cdec; \
            _Pragma("unroll") for (int s = 0; s < 2; ++s) { const bf16_t* kp = KT + (32 * s + 4 * g + tq) * 72 + 16 * dt + 4 * tp; t = MFMA16(cat8(trread(kp), trread(kp + 16 * 72)), Vb[s], t); } \
            S[dt] = t; } \
        float* rb = red + ((n) & 1) * 512; \
        _Pragma("unroll") for (int m = 0; m < 2; ++m) _Pragma("unroll") for (int r = 0; r < 4; ++r) { float q = out[m][r] * out[m][r]; ROW_SUM16(q); \
            if (c == 0) rb[w * 64 + 16 * m + 4 * g + r] = q; } \
        if ((n) + 2 < 32) RET_STORE(X, ((n) + 2) % 3); \
        __syncthreads(); \
        _Pragma("unroll") for (int m = 0; m < 2; ++m) { f32x4 tot = *(const f32x4*)(rb + 16 * m + 4 * g); \
            _Pragma("unroll") for (int q = 1; q < 8; ++q) tot = tot + *(const f32x4*)(rb + q * 64 + 16 * m + 4 * g); \
            _Pragma("unroll") for (int r = 0; r < 4; ++r) OT[((n) & 1) * 4224 + (16 * m + 4 * g + r) * 132 + 16 * w + c] = out[m][r] * rsqrtf(tot[r] * (1.f / 128.f) + EPSF); } \
        if ((n) >= 1) { const float* op = OT + (((n) - 1) & 1) * 4224 + tokrow * 132 + 8 * cp; const f32x4 a0 = *(const f32x4*)op, a1 = *(const f32x4*)(op + 4); float gg[8]; unpack8(gq, gg); \
            u32x4 wo; wo.x = pk2(a0[0] * gg[0], a0[1] * gg[1]); wo.y = pk2(a0[2] * gg[2], a0[3] * gg[3]); wo.z = pk2(a1[0] * gg[4], a1[1] * gg[5]); wo.w = pk2(a1[2] * gg[6], a1[3] * gg[7]); \
            *(u32x4*)(BRC + tokp * 512 + h * 128 + 8 * cp) = wo; } \
    } while (0)
    for (int n = 0; n < 32; n += 2) { RET_STEP(n, stA, stB); RET_STEP(n + 1, stB, stA); }
    __syncthreads();
    {
        const size_t tokp = (size_t)b * SEQL + 31 * 64 + 16 * ((tokrow >> 4) ? itB : itA) + (tokrow & 15);
        const u32x4 gq = *(const u32x4*)(R + tokp * 1536 + 1024 + h * 128 + 8 * cp);
        const float* op = OT + 4224 + tokrow * 132 + 8 * cp; const f32x4 a0 = *(const f32x4*)op, a1 = *(const f32x4*)(op + 4); float gg[8]; unpack8(gq, gg);
        u32x4 wo; wo.x = pk2(a0[0] * gg[0], a0[1] * gg[1]); wo.y = pk2(a0[2] * gg[2], a0[3] * gg[3]); wo.z = pk2(a1[0] * gg[4], a1[1] * gg[5]); wo.w = pk2(a1[2] * gg[6], a1[3] * gg[7]);
        *(u32x4*)(BRC + tokp * 512 + h * 128 + 8 * cp) = wo;
    }
#undef RET_STEP
#undef RET_PTILE
#undef RET_LOAD
#undef RET_STORE
}

DI void attn_item(const Params& p, int l, int item, unsigned char* lds, int tid) {
    float zz = 0.f; unsigned zu = 0u; asm volatile("" : "+v"(zz), "+v"(zu));
    const int kvh = item & 1, nb = (item >> 1) & 15, b = item >> 5, lane = tid & 63, wave = tid >> 6, c = lane & 15, g = lane >> 4;
    bf16_t* KS = (bf16_t*)lds; bf16_t* VT = KS + 256 * 72;
    const bf16_t* A = (const bf16_t*)(p.ws + OFF_AQKV); const float* TA = (const float*)(p.ws + OFF_TA); bf16_t* BRA = (bf16_t*)(p.ws + OFF_DQKV);
    const float* qn = p.in[9] + l * 64; const float* kn = p.in[10] + l * 64;
    {
        const int d0 = (tid & 7) * 8;
#pragma unroll
        for (int pz = 0; pz < 4; ++pz) { const int jj = pz * 64 + (tid >> 3), pos = (nb - 1) * 128 + jj;
            float k[8]; u32x4 vv = (u32x4){zu, zu, zu, zu};
            if (pos >= 0) { const size_t tok = (size_t)b * SEQL + pos; unpack8(*(const u32x4*)(A + tok * 768 + 512 + kvh * 64 + d0), k); vv = *(const u32x4*)(A + tok * 768 + 640 + kvh * 64 + d0); }
            else { for (int e = 0; e < 8; ++e) k[e] = 0.f; }
            float ss = 0.f;
#pragma unroll
            for (int e = 0; e < 8; ++e) ss += k[e] * k[e];
            ss += __shfl_xor(ss, 1); ss += __shfl_xor(ss, 2); ss += __shfl_xor(ss, 4);
            const float r = rsqrtf(ss * (1.f / 64.f) + EPSF);
            float part[8];
#pragma unroll
            for (int e = 0; e < 8; ++e) { k[e] = k[e] * r * kn[d0 + e]; part[e] = __shfl_xor(k[e], 1); }
            if (d0 < 16 && pos >= 0) {
#pragma unroll
                for (int e = 0; e < 8; ++e) { const float cs = TA[(pos * 8 + e) * 2], sn = TA[(pos * 8 + e) * 2 + 1];
                    k[e] = (d0 == 0) ? (k[e] * cs - part[e] * sn) : (k[e] * cs + part[e] * sn); } }
            u32x4 wk; wk.x = pk2(k[0], k[1]); wk.y = pk2(k[2], k[3]); wk.z = pk2(k[4], k[5]); wk.w = pk2(k[6], k[7]);
            *(u32x4*)(KS + jj * 72 + d0) = wk;
            const unsigned vw[4] = {vv.x, vv.y, vv.z, vv.w};
#pragma unroll
            for (int e = 0; e < 4; ++e) { VT[(d0 + 2 * e) * 264 + jj] = (bf16_t)(vw[e] & 0xffffu); VT[(d0 + 2 * e + 1) * 264 + jj] = (bf16_t)(vw[e] >> 16); }
        }
    }
    __syncthreads();
    const int hq = kvh * 4 + (wave >> 1); const float sink = p.in[11][l * 8 + hq];
    for (int ai = 0; ai < 4; ++ai) { const int a = (wave & 1) * 4 + ai;
        const int pos = nb * 128 + 16 * a + c; const size_t tok = (size_t)b * SEQL + pos;
        float q[16]; unpack8(*(const u32x4*)(A + tok * 768 + hq * 64 + 8 * g), q); unpack8(*(const u32x4*)(A + tok * 768 + hq * 64 + 32 + 8 * g), q + 8);
        float ss = 0.f;
#pragma unroll
        for (int e = 0; e < 16; ++e) ss += q[e] * q[e];
        ss += __shfl_xor(ss, 16); ss += __shfl_xor(ss, 32);
        const float r = rsqrtf(ss * (1.f / 64.f) + EPSF);
#pragma unroll
        for (int e = 0; e < 8; ++e) { q[e] = q[e] * r * qn[8 * g + e]; q[8 + e] = q[8 + e] * r * qn[32 + 8 * g + e]; }
        float part[8];
#pragma unroll
        for (int e = 0; e < 8; ++e) part[e] = __shfl_xor(q[e], 16);
        if (g < 2) {
#pragma unroll
            for (int e = 0; e < 8; ++e) { const float cs = TA[(pos * 8 + e) * 2], sn = TA[(pos * 8 + e) * 2 + 1];
                q[e] = (g == 0) ? (q[e] * cs - part[e] * sn) : (q[e] * cs + part[e] * sn); } }
        bf16x8 qb[2];
        { u32x4 w0, w1; w0.x = pk2(q[0] * .125f, q[1] * .125f); w0.y = pk2(q[2] * .125f, q[3] * .125f); w0.z = pk2(q[4] * .125f, q[5] * .125f); w0.w = pk2(q[6] * .125f, q[7] * .125f);
          w1.x = pk2(q[8] * .125f, q[9] * .125f); w1.y = pk2(q[10] * .125f, q[11] * .125f); w1.z = pk2(q[12] * .125f, q[13] * .125f); w1.w = pk2(q[14] * .125f, q[15] * .125f);
          qb[0] = __builtin_bit_cast(bf16x8, w0); qb[1] = __builtin_bit_cast(bf16x8, w1); }
        f32x4 P[10]; float mx = sink;
#pragma unroll
        for (int jp = 0; jp < 9; ++jp) { const int jt = a + jp;
            const bf16x8 k0 = *(const bf16x8*)(KS + (16 * jt + c) * 72 + 8 * g), k1 = *(const bf16x8*)(KS + (16 * jt + c) * 72 + 32 + 8 * g);
            f32x4 t = (f32x4){zz, zz, zz, zz}; t = MFMA16(k0, qb[0], t); t = MFMA16(k1, qb[1], t);
#pragma unroll
            for (int rr = 0; rr < 4; ++rr) { const int kj = 16 * jt + 4 * g + rr, qi = 16 * a + c; const bool ok = (kj > qi) && (kj <= qi + 128) && (nb > 0 || kj >= 128);
                t[rr] = ok ? t[rr] : -1e30f; mx = fmaxf(mx, t[rr]); }
            P[jp] = t; }
        P[9] = (f32x4){zz, zz, zz, zz};
        mx = fmaxf(mx, __shfl_xor(mx, 16)); mx = fmaxf(mx, __shfl_xor(mx, 32));
        float sum = 0.f;
#pragma unroll
        for (int jp = 0; jp < 9; ++jp)
#pragma unroll
            for (int rr = 0; rr < 4; ++rr) { const float e = __expf(P[jp][rr] - mx); P[jp][rr] = e; sum += e; }
        sum += __shfl_xor(sum, 16); sum += __shfl_xor(sum, 32);
        const float inv = 1.f / (sum + __expf(sink - mx));
#pragma unroll
        for (int jp = 0; jp < 9; ++jp) P[jp] = P[jp] * inv;
        f32x4 o[4];
#pragma unroll
        for (int nt = 0; nt < 4; ++nt) o[nt] = (f32x4){zz, zz, zz, zz};
#pragma unroll
        for (int s = 0; s < 5; ++s) { const bf16x8 pa = pack8(P[2 * s], P[2 * s + 1]);
#pragma unroll
            for (int nt = 0; nt < 4; ++nt) { const bf16_t* vp = VT + (16 * nt + c) * 264 + 16 * (a + 2 * s) + 4 * g;
                const u32x2 lo = *(const u32x2*)vp; const u32x2 hi = (s < 4) ? *(const u32x2*)(vp + 16) : (u32x2){zu, zu};
                o[nt] = MFMA16(pa, cat8(lo, hi), o[nt]); } }
#pragma unroll
        for (int nt = 0; nt < 4; ++nt)
#pragma unroll
            for (int rr = 0; rr < 4; ++rr) { const size_t tk = (size_t)b * SEQL + nb * 128 + 16 * a + 4 * g + rr; BRA[tk * 512 + hq * 64 + 16 * nt + c] = (bf16_t)f2bf(o[nt][rr]); }
    }
    __syncthreads();
}
constexpr int N_PHASES = 25;
#ifndef COOP
#define COOP 1
#endif
DI void fast_grid_barrier(unsigned* ctr, unsigned target) {
    asm volatile("s_waitcnt vmcnt(0)" ::: "memory");
    __syncthreads();
    if (threadIdx.x == 0) {
        __builtin_amdgcn_fence(__ATOMIC_RELEASE, "agent");
        asm volatile("s_waitcnt vmcnt(0)" ::: "memory");
        __hip_atomic_fetch_add(ctr, 1u, __ATOMIC_RELAXED, __HIP_MEMORY_SCOPE_AGENT);
        while (__hip_atomic_load(ctr, __ATOMIC_RELAXED, __HIP_MEMORY_SCOPE_AGENT) < target) __builtin_amdgcn_s_sleep(1);
        __builtin_amdgcn_fence(__ATOMIC_ACQUIRE, "agent");
        asm volatile("s_waitcnt vmcnt(0)" ::: "memory");
    }
    __syncthreads();
}
__global__ void __launch_bounds__(512, 2) mega_fwd(Params p) {
    extern __shared__ __attribute__((aligned(16))) unsigned char lds_raw[];
    const int G0 = gridDim.x, bx0 = blockIdx.x, wv0 = __builtin_amdgcn_readfirstlane((int)(threadIdx.x >> 6)); unsigned nbar = 0;
#ifndef REP_S
#define REP_S -1
#define REP_N 0
#endif
#ifndef REP_L
#define REP_L -1
#endif
    for (int phx = p.ph_lo * (1 + REP_N); phx < p.ph_hi * (1 + REP_N); ++phx) {
        const int ph = phx / (1 + REP_N);
        if (REP_N > 0 && (phx % (1 + REP_N)) != 0 && !(ph > 0 && (ph - 1) % 12 == REP_S && (REP_L < 0 || (ph - 1) / 12 == REP_L))) continue;
        if (phx > p.ph_lo * (1 + REP_N)) {
            if (phx == p.ph_lo * (1 + REP_N) + 1) cg::this_grid().sync();
            else { ++nbar; fast_grid_barrier((unsigned*)(p.ws + OFF_CTR), nbar * (unsigned)G0); }
        }
#ifdef SYNC_ONLY
        if ((phx % (1 + REP_N)) != 0) continue;
#endif
        typedef __attribute__((address_space(4))) const Params* KP;
        KP kp = (KP)__builtin_amdgcn_kernarg_segment_ptr();
        int wvi = wv0; asm volatile("" : "+s"(wvi));
        unsigned ones = ~0u; asm volatile("" : "+s"(ones));
        int tid = wvi * 64 + (int)__builtin_amdgcn_mbcnt_hi(ones, __builtin_amdgcn_mbcnt_lo(ones, 0u)), G = G0, bx = bx0;
        asm volatile("" : "+v"(tid), "+s"(G), "+s"(bx), "+s"(kp) :: "memory");
        const Params& P = *(const Params*)kp; unsigned char* ws = P.ws;
        PG8_LAS unsigned char* ldsl = (PG8_LAS unsigned char*)lds_raw; asm volatile("" : "+v"(ldsl));
        unsigned char* lds = (unsigned char*)ldsl;
        float* MOD = (float*)(ws + OFF_MOD);
        if (ph == 0) { phase_mod(P, lds, tid); continue; }
        const int q = ph - 1, l = q / 12, s = q % 12;
        const float* xsrc = (l == 0 && s <= 2) ? P.in[0] : P.out;
        float* modl = MOD + (size_t)l * 8 * NMODW;
        if (s == 0 || s == 3 || s == 9) { phase_prep(P, l, s == 0 ? 0 : (s == 3 ? 1 : 2), xsrc, lds, tid); }
        else if (s == 1 || s == 10) {
            pg8::Gemm g{(const bf16_t*)(ws + OFF_U), (const bf16_t*)(ws + OFF_W13T), MT, 2 * DFF, DM}; pg8::StaticOrder S; S.init(MT, 2 * DFF, G, bx);
            EpiSwiGLU E{(bf16_t*)(ws + OFF_H)};
            pg8::gemm_phase<EpiSwiGLU, pg8::StaticOrder, true, true>(ldsl, g, S, E, tid);
        } else if (s == 2 || s == 8 || s == 11) {
            pg8::Gemm g{(const bf16_t*)(ws + (s == 8 ? OFF_U : OFF_H)), (const bf16_t*)(ws + (s == 8 ? OFF_WOT : OFF_W2T)), MT, DM, s == 8 ? DM : DFF}; pg8::StaticOrder S; S.init(MT, DM, G, bx);
            EpiResid E{xsrc, P.out, modl + (s == 2 ? 2 : (s == 8 ? 5 : 8)) * DM, s == 8 ? 1.f : 0.5f};
            pg8::gemm_phase<EpiResid, pg8::StaticOrder, false, true>(ldsl, g, S, E, tid);
        } else if (s == 4) {
            pg8::Gemm g{(const bf16_t*)(ws + OFF_U), (const bf16_t*)(ws + OFF_WINT), MT, NPROJ, DM}; pg8::StaticOrder S; S.init(MT, NPROJ, G, bx);
            EpiProj E{ws};
            pg8::gemm_phase<EpiProj, pg8::StaticOrder, true, true>(ldsl, g, S, E, tid);
        } else if (s == 5) {
            { u32x4 pre[12]; dn_prep_fetch(P, bx < 2048 ? bx : 0, tid, pre);
              for (int it = bx; it < 2048; it += G) { int tl = tid; asm volatile("" : "+v"(tl)); dn_prep_item(P, l, it, it + G, pre, lds, tl); } }
        } else if (s == 6) {
            const int stride = (G > 192) ? ((bx < 128) ? (1 << 20) : (G - 128)) : G;
            for (int it = bx; it < 384; it += stride) {
                int tl = tid; asm volatile("" : "+v"(tl));
#ifdef ROLE_ONLY
                if ((phx % (1 + REP_N)) != 0 && (it < 64 ? 0 : (it < 128 ? 1 : 2)) != ROLE_ONLY) continue;
#endif
                if (it < 64) dn_scan_wg(P, l, it, lds, tl);
                else if (it < 128) ret_scan_wg(P, l, it - 64, lds, tl);
                else attn_item(P, l, it - 128, lds, tl);
                __syncthreads();
            }
        } else if (s == 7) {
            pg8::Gemm g{(const bf16_t*)(ws + OFF_DQKV), (const bf16_t*)(ws + OFF_WBT), 3 * MT, 3 * DM, 512}; MergeOrder S{G, bx};
            EpiMerge E{(const bf16_t*)(ws + OFF_GATES), (bf16_t*)(ws + OFF_U)};
            pg8::gemm_phase<EpiMerge, MergeOrder, true, true>(ldsl, g, S, E, tid);
        }
    }
}

extern "C" void kernel_launch(void* const* d_in, const int* in_sizes, int n_in, void* d_out, int out_size, void* d_ws, size_t ws_size, hipStream_t stream) {
    static int grid = 0;
    if (grid == 0) {
        int dev = 0, cus = 0, per_cu = 0;
        hipGetDevice(&dev); hipDeviceGetAttribute(&cus, hipDeviceAttributeMultiprocessorCount, dev);
        hipFuncSetAttribute((const void*)mega_fwd, hipFuncAttributeMaxDynamicSharedMemorySize, LDS_BYTES);
        hipOccupancyMaxActiveBlocksPerMultiprocessor(&per_cu, (const void*)mega_fwd, 512, LDS_BYTES);
        if (per_cu < 1) per_cu = 1;
        grid = cus * per_cu; if (grid > 256) grid = 256;
        if (ws_size < WS_END) fprintf(stderr, "kernel_launch: workspace too small: %zu < %zu\n", ws_size, (size_t)WS_END);
        (void)hipGetLastError();
    }
    hipMemsetAsync((unsigned char*)d_ws + OFF_CTR, 0, 256, stream);
    Params p{};
    for (int i = 0; i < 21; ++i) p.in[i] = (const float*)d_in[i];
    p.out = (float*)d_out; p.ws = (unsigned char*)d_ws;
#if COOP
    p.ph_lo = 0; p.ph_hi = N_PHASES;
    void* args[] = {&p};
    hipError_t e = hipLaunchCooperativeKernel((const void*)mega_fwd, dim3(grid), dim3(512), args, LDS_BYTES, stream);
    if (e != hipSuccess) fprintf(stderr, "cooperative launch failed: %s (grid %d)\n", hipGetErrorString(e), grid);
#else
    for (int ph = 0; ph < N_PHASES; ++ph) { p.ph_lo = ph; p.ph_hi = ph + 1; hipLaunchKernelGGL(mega_fwd, dim3(grid), dim3(512), LDS_BYTES, stream, p); }
#endif
}
```

```cpp
#include <hip/hip_runtime.h>
#include <hip/hip_cooperative_groups.h>
#include <cstdio>
#include <cstdint>
namespace pg8 {
#define PG8_LAS __attribute__((address_space(3)))
typedef unsigned short bf16_t;
typedef short bf16x8 __attribute__((ext_vector_type(8)));
typedef float f32x4 __attribute__((ext_vector_type(4)));
typedef unsigned u32x4 __attribute__((ext_vector_type(4)));
constexpr int BM = 256, BK = 64, HALF = 128, HTB = HALF * BK * 2  , STAGE_BYTES = 8 * HTB, NXCD = 8, WGM = 8;

__host__ __device__ __forceinline__ int lds_byte(int r, int c) { const int st = (r >> 4) * 2 + (c >> 5), rr = r & 15, cc = c & 31, ob = rr * 64 + cc * 2; return st * 1024 + (ob ^ (((ob >> 9) & 1) << 5)); }
__host__ __device__ __forceinline__ void stage_rc(int b, int& R, int& C) { const int st = b / 1024, sb = b % 1024, swz = sb ^ (((sb >> 9) & 1) << 5); R = (st >> 1) * 16 + swz / 64; C = (st & 1) * 32 + (swz % 64) / 2; }
__host__ __device__ __forceinline__ int perm32(int rho) { const int n = rho >> 4, i = rho & 15; return 8 * (i >> 2) + 4 * n + (i & 3); }

struct Unit { int pm, pn; };
struct Gemm { const bf16_t* A; const bf16_t* Bt; int M, N, K; };

struct StaticOrder {
    int nM, nN, nwg, G, c;
    __host__ __device__ void init(int M, int N, int G_, int c_) { nM = M / BM; nN = N / BM; nwg = nM * nN; G = G_; c = c_; }
    __host__ __device__ bool next(int i, Unit& u) const {
        const long L = (long)i * G + c; if (L >= nwg) return false;
        int wgid = (int)L; { const int q = nwg / NXCD, r = nwg % NXCD, xcd = wgid % NXCD, off = wgid / NXCD; wgid = (xcd < r ? xcd * (q + 1) : r * (q + 1) + (xcd - r) * q) + off; }
        const int nig = WGM * nN, gid = wgid / nig, fm = gid * WGM, gsz = (nM - fm) < WGM ? (nM - fm) : WGM;
        u.pm = fm + ((wgid % nig) % gsz); u.pn = (wgid % nig) / gsz; return true;
    }
    __device__ __forceinline__ void a_ready(const Unit&) const {}
    __device__ __forceinline__ void done(const Unit&) const {}
};

__device__ __forceinline__ unsigned cvt_pk_bf16(float lo, float hi) { unsigned r; asm volatile("v_cvt_pk_bf16_f32 %0, %1, %2" : "=v"(r) : "v"(lo), "v"(hi)); return r; }
typedef float f32x2 __attribute__((ext_vector_type(2)));
template <class Epi, class Sched, bool ALIGN_EPI = false, bool SP2 = false>
__device__ __forceinline__ void gemm_phase(PG8_LAS unsigned char* lds, const Gemm g, const Sched& S, const Epi& E, const int tid) {
    const int wid = __builtin_amdgcn_readfirstlane(tid >> 6), lane = tid & 63, wr = wid >> 2, wc = wid & 3, fr = lane & 15, fq = lane >> 4;
    const int K = g.K, nt = K / BK; float zz = 0.f; asm volatile("" : "+v"(zz));
    unsigned voffA[2], voffB[2];
#pragma unroll
    for (int i = 0; i < 2; ++i) { int R, C; stage_rc(tid * 16 + i * 8192, R, C); const int Rb = Epi::PERM ? ((R & ~31) + perm32(R & 31)) : R;
        voffA[i] = (unsigned)(R * K + C) * 2u; voffB[i] = (unsigned)(Rb * K + C) * 2u; }
    const size_t kstep = (size_t)(BK * 2);
    const size_t hstep = (size_t)HALF * K * 2;
    const size_t tstep = 2 * hstep;
    const unsigned ldsw = (unsigned)wid * 1024u;
    const int aoff = lds_byte(wr * 64 + fr, fq * 8), boff = lds_byte(wc * 32 + fr, fq * 8);
#define PG8_SA(b, h) (((b) * 2 + (h)) * HTB)
#define PG8_SB(b, h) ((4 + (b) * 2 + (h)) * HTB)
#define PG8_STAGE(bufoff, gbase, voff) do { _Pragma("unroll") for (int _i = 0; _i < 2; ++_i) \
        __builtin_amdgcn_global_load_lds((const unsigned*)((const char*)(gbase) + (voff)[_i]), (PG8_LAS unsigned*)(lds + (bufoff) + ldsw + _i * 8192), 16, 0, 0); } while (0)
#define PG8_LDA(dst, b, h) do { _Pragma("unroll") for (int m = 0; m < 4; ++m) _Pragma("unroll") for (int k = 0; k < 2; ++k) dst[m][k] = *(const PG8_LAS bf16x8*)(lds + PG8_SA(b, h) + aoff + m * 2048 + k * 1024); } while (0)
#define PG8_LDB(dst, b, h) do { _Pragma("unroll") for (int n = 0; n < 2; ++n) _Pragma("unroll") for (int k = 0; k < 2; ++k) dst[n][k] = *(const PG8_LAS bf16x8*)(lds + PG8_SB(b, h) + boff + n * 2048 + k * 1024); } while (0)
#define PG8_MMA(ai, bj, At, Bt) do { __builtin_amdgcn_s_setprio(1); _Pragma("unroll") for (int m = 0; m < 4; ++m) _Pragma("unroll") for (int n = 0; n < 2; ++n) _Pragma("unroll") for (int k = 0; k < 2; ++k) \
        acc[ai][bj][m][n] = __builtin_amdgcn_mfma_f32_16x16x32_bf16(Bt[n][k], At[m][k], acc[ai][bj][m][n], 0, 0, 0); __builtin_amdgcn_s_setprio(0); } while (0)
#define PG8_WAIT_V(n) asm volatile("s_waitcnt vmcnt(" #n ")" ::: "memory")
#define PG8_WAIT_L(n) asm volatile("s_waitcnt lgkmcnt(" #n ")" ::: "memory")
#define PG8_BAR __builtin_amdgcn_s_barrier()
#define PG8_SCHED __builtin_amdgcn_sched_barrier(0)
    Unit cur, nxt; int ui = 0;
    if (!S.next(0, cur)) return;
    f32x4 acc[2][2][4][2];
#pragma unroll
    for (int a = 0; a < 2; ++a)
#pragma unroll
        for (int b = 0; b < 2; ++b)
#pragma unroll
            for (int m = 0; m < 4; ++m)
#pragma unroll
                for (int n = 0; n < 2; ++n) acc[a][b][m][n] = (f32x4){zz, zz, zz, zz};
    bf16x8 At[4][2], B0[2][2], B1[2][2];
    const char* cA = (const char*)g.A + (size_t)cur.pm * tstep; const char* cB = (const char*)g.Bt + (size_t)cur.pn * tstep;
    S.a_ready(cur);
    if constexpr (SP2) {
        PG8_STAGE(PG8_SB(0, 0), cB, voffB); PG8_STAGE(PG8_SB(0, 1), cB + hstep, voffB); PG8_STAGE(PG8_SA(0, 0), cA, voffA); PG8_STAGE(PG8_SA(0, 1), cA + hstep, voffA);
        if (wr == 1) PG8_BAR;
        PG8_WAIT_V(2); PG8_BAR;
        PG8_STAGE(PG8_SB(1, 0), cB + kstep, voffB); PG8_STAGE(PG8_SA(1, 0), cA + kstep, voffA); PG8_STAGE(PG8_SB(1, 1), cB + hstep + kstep, voffB);
        PG8_WAIT_V(6); PG8_BAR;
    } else {
        PG8_STAGE(PG8_SB(0, 0), cB, voffB); PG8_STAGE(PG8_SA(0, 0), cA, voffA); PG8_STAGE(PG8_SB(0, 1), cB + hstep, voffB); PG8_STAGE(PG8_SA(0, 1), cA + hstep, voffA);
        if (wr == 1) PG8_BAR;
        PG8_WAIT_V(4); PG8_BAR;
        PG8_STAGE(PG8_SB(1, 0), cB + kstep, voffB); PG8_STAGE(PG8_SA(1, 0), cA + kstep, voffA); PG8_STAGE(PG8_SB(1, 1), cB + hstep + kstep, voffB);
        PG8_WAIT_V(6); PG8_BAR;
    }
    for (;;) {
        const bool has_next = S.next(ui + 1, nxt);
        const char* nA = has_next ? (const char*)g.A + (size_t)nxt.pm * tstep : cA; const char* nB = has_next ? (const char*)g.Bt + (size_t)nxt.pn * tstep : cB;
        for (int t = 0; t < nt; t += 2) {
            const bool last = (t == nt - 2);
            const char* a1 = cA + (size_t)(t + 1) * kstep;
            const char* a2 = last ? nA : cA + (size_t)(t + 2) * kstep; const char* b2 = last ? nB : cB + (size_t)(t + 2) * kstep;
            const char* a3 = a2 + kstep; const char* b3 = b2 + kstep;
            if (last && has_next) S.a_ready(nxt);
            if constexpr (SP2) {
            PG8_LDB(B0, 0, 0); PG8_LDB(B1, 0, 1); PG8_SCHED; PG8_LDA(At, 0, 0); PG8_STAGE(PG8_SA(1, 1), a1 + hstep, voffA);
            PG8_WAIT_V(8); PG8_WAIT_L(0); PG8_BAR; PG8_MMA(0, 0, At, B0); PG8_MMA(0, 1, At, B1); PG8_BAR; PG8_SCHED;
            PG8_LDA(At, 0, 1); PG8_STAGE(PG8_SB(0, 0), b2, voffB); PG8_STAGE(PG8_SB(0, 1), b2 + hstep, voffB); PG8_STAGE(PG8_SA(0, 0), a2, voffA);
            PG8_WAIT_V(8); PG8_WAIT_L(0); PG8_BAR; PG8_MMA(1, 0, At, B0); PG8_MMA(1, 1, At, B1); PG8_BAR; PG8_SCHED;
            PG8_LDB(B0, 1, 0); PG8_LDB(B1, 1, 1); PG8_SCHED; PG8_LDA(At, 1, 0); PG8_STAGE(PG8_SA(0, 1), a2 + hstep, voffA);
            PG8_WAIT_V(8); PG8_WAIT_L(0); PG8_BAR; PG8_MMA(0, 0, At, B0); PG8_MMA(0, 1, At, B1); PG8_BAR; PG8_SCHED;
            PG8_LDA(At, 1, 1); PG8_STAGE(PG8_SB(1, 0), b3, voffB); PG8_STAGE(PG8_SB(1, 1), b3 + hstep, voffB); PG8_STAGE(PG8_SA(1, 0), a3, voffA);
            PG8_WAIT_V(8); PG8_WAIT_L(0); PG8_BAR; PG8_MMA(1, 0, At, B0); PG8_MMA(1, 1, At, B1); PG8_BAR; PG8_SCHED;
            } else {
            PG8_LDB(B0, 0, 0); PG8_SCHED; PG8_LDA(At, 0, 0); PG8_STAGE(PG8_SA(1, 1), a1 + hstep, voffA);
            PG8_WAIT_L(8); PG8_BAR; PG8_WAIT_L(0); PG8_MMA(0, 0, At, B0); PG8_BAR; PG8_SCHED;
            PG8_LDB(B1, 0, 1); PG8_STAGE(PG8_SB(0, 0), b2, voffB);
            PG8_BAR; PG8_WAIT_L(0); PG8_MMA(0, 1, At, B1); PG8_BAR;
            PG8_LDA(At, 0, 1); PG8_STAGE(PG8_SA(0, 0), a2, voffA);
            PG8_BAR; PG8_WAIT_L(0); PG8_MMA(1, 0, At, B0); PG8_BAR; PG8_SCHED;
            PG8_STAGE(PG8_SB(0, 1), b2 + hstep, voffB);
            PG8_WAIT_V(6); PG8_BAR; PG8_MMA(1, 1, At, B1); PG8_BAR;
            PG8_LDB(B0, 1, 0); PG8_SCHED; PG8_LDA(At, 1, 0); PG8_STAGE(PG8_SA(0, 1), a2 + hstep, voffA);
            PG8_WAIT_L(8); PG8_BAR; PG8_WAIT_L(0); PG8_MMA(0, 0, At, B0); PG8_BAR; PG8_SCHED;
            PG8_LDB(B1, 1, 1); PG8_STAGE(PG8_SB(1, 0), b3, voffB);
            PG8_BAR; PG8_WAIT_L(0); PG8_MMA(0, 1, At, B1); PG8_BAR;
            PG8_LDA(At, 1, 1); PG8_STAGE(PG8_SA(1, 0), a3, voffA);
            PG8_BAR; PG8_WAIT_L(0); PG8_MMA(1, 0, At, B0); PG8_BAR; PG8_SCHED;
            PG8_STAGE(PG8_SB(1, 1), b3 + hstep, voffB);
            PG8_WAIT_V(6); PG8_BAR; PG8_MMA(1, 1, At, B1); PG8_BAR;
            }
        }
        if constexpr (ALIGN_EPI) { if (wr == 0) PG8_BAR; }
        if constexpr (!Epi::AFTER_DRAIN) { E(acc, cur, wr, wc, fr, fq); S.done(cur); }
        if (!has_next) break;
        if (E.zero_after(cur)) {
#pragma unroll
        for (int a = 0; a < 2; ++a)
#pragma unroll
            for (int b = 0; b < 2; ++b)
#pragma unroll
                for (int m = 0; m < 4; ++m)
#pragma unroll
                    for (int n = 0; n < 2; ++n) acc[a][b][m][n] = (f32x4){zz, zz, zz, zz};
        }
        cur = nxt; cA = nA; cB = nB; ++ui;
        if constexpr (ALIGN_EPI) { if (wr == 1) PG8_BAR; }
    }
    PG8_WAIT_V(0);
    if constexpr (!ALIGN_EPI) { if (wr == 0) PG8_BAR; }
    PG8_BAR;
    if constexpr (Epi::AFTER_DRAIN) { E.fused(acc, cur, wr, wc, fr, fq, lds, wid, lane); S.done(cur); }
#undef PG8_SA
#undef PG8_SB
#undef PG8_STAGE
#undef PG8_LDA
#undef PG8_LDB
#undef PG8_MMA
#undef PG8_WAIT_V
#undef PG8_WAIT_L
#undef PG8_BAR
#undef PG8_SCHED
}
}
namespace cg = cooperative_groups;
using pg8::bf16_t; using pg8::bf16x8; using pg8::f32x4; using pg8::u32x4; using pg8::Unit;
typedef unsigned u32x2 __attribute__((ext_vector_type(2)));
#define DI __device__ __forceinline__
#define MFMA16(a, b, c) __builtin_amdgcn_mfma_f32_16x16x32_bf16((a), (b), (c), 0, 0, 0)

constexpr int MT = 16384, DM = 1024, SEQL = 2048, DFF = 2816, NPROJ = 7680, NMODW = 9216;
constexpr float EPSF = 1e-6f;
constexpr size_t OFF_CTR = 3u << 20;
constexpr size_t OFF_MOD = 0, OFF_TA = 1u << 20, OFF_TR = OFF_TA + 131072, OFF_CD = OFF_TR + 524288, OFF_DAB = 2u << 20;
constexpr size_t OFF_W = 4u << 20, OFF_U = OFF_W + 22544384, OFF_BIG = OFF_U + 83886080;
constexpr size_t OFF_H = OFF_BIG, OFF_AQKV = OFF_BIG, OFF_DQKV = OFF_AQKV + 25165824, OFF_DZ = OFF_DQKV + 50331648;
constexpr size_t OFF_R = OFF_DZ + 16777216, OFF_GATES = OFF_R + 50331648, WS_END = OFF_GATES + 100663296;
constexpr size_t OFF_WBT = OFF_W, OFF_WOT = OFF_W + 3145728, OFF_W13T = OFF_W + 5242880, OFF_W2T = OFF_W + 16777216;
constexpr size_t OFF_WINT = OFF_U + 33554432;
constexpr int LDS_BYTES = 159744;

struct Params { const float* in[21]; float* out; unsigned char* ws; int ph_lo, ph_hi; };

DI unsigned f2bf(float f) { unsigned u = __builtin_bit_cast(unsigned, f); return (u + 0x7fffu + ((u >> 16) & 1u)) >> 16; }
typedef float f32x2_t __attribute__((ext_vector_type(2))); typedef __bf16 bf16x2_t __attribute__((ext_vector_type(2)));
DI unsigned pk2(float lo, float hi) { f32x2_t v = {lo, hi}; bf16x2_t b = __builtin_convertvector(v, bf16x2_t); return __builtin_bit_cast(unsigned, b); }
#define dpp_f(x, ctrl) __builtin_bit_cast(float, __builtin_amdgcn_update_dpp(0, __builtin_bit_cast(int, (x)), (ctrl), 0xf, 0xf, false))
#define ROW_SUM16(x) do { x += dpp_f(x, 0xB1); x += dpp_f(x, 0x4E); x += dpp_f(x, 0x141); x += dpp_f(x, 0x140); } while (0)
DI float bflo(unsigned w) { return __builtin_bit_cast(float, w << 16); }
DI float bfhi(unsigned w) { return __builtin_bit_cast(float, w & 0xffff0000u); }
DI float bf1(bf16_t h) { return __builtin_bit_cast(float, (unsigned)h << 16); }
DI float silu_f(float x) { return x * __builtin_amdgcn_rcpf(1.f + __builtin_amdgcn_exp2f(-1.4426950408889634f * x)); }
DI float sigm_f(float x) { return __builtin_amdgcn_rcpf(1.f + __builtin_amdgcn_exp2f(-1.4426950408889634f * x)); }
DI bf16x8 pack8(f32x4 a, f32x4 b) { u32x4 w; w.x = pk2(a[0], a[1]); w.y = pk2(a[2], a[3]); w.z = pk2(b[0], b[1]); w.w = pk2(b[2], b[3]); return __builtin_bit_cast(bf16x8, w); }
DI bf16x8 cat8(u32x2 a, u32x2 b) { u32x4 w; w.x = a.x; w.y = a.y; w.z = b.x; w.w = b.y; return __builtin_bit_cast(bf16x8, w); }
DI void unpack8(u32x4 w, float* f) { f[0] = bflo(w.x); f[1] = bfhi(w.x); f[2] = bflo(w.y); f[3] = bfhi(w.y); f[4] = bflo(w.z); f[5] = bfhi(w.z); f[6] = bflo(w.w); f[7] = bfhi(w.w); }

struct EpiSwiGLU { static constexpr bool PERM = true, AFTER_DRAIN = false; bf16_t* H;
    DI bool zero_after(const Unit&) const { return true; }
    DI void operator()(const f32x4 (&acc)[2][2][4][2], const Unit& u, int wr, int wc, int fr, int fq) const {
        const int row0 = u.pm * 256 + wr * 64 + fr, col0 = u.pn * 128 + wc * 32 + 8 * fq;
#pragma unroll
        for (int ai = 0; ai < 2; ++ai)
#pragma unroll
            for (int m = 0; m < 4; ++m) { bf16_t* p = H + (size_t)(row0 + ai * 128 + m * 16) * DFF + col0;
                const f32x4 g0 = acc[ai][0][m][0], g1 = acc[ai][0][m][1], u0 = acc[ai][1][m][0], u1 = acc[ai][1][m][1];
                u32x4 w; w.x = pk2(silu_f(g0[0]) * u0[0], silu_f(g0[1]) * u0[1]); w.y = pk2(silu_f(g0[2]) * u0[2], silu_f(g0[3]) * u0[3]);
                w.z = pk2(silu_f(g1[0]) * u1[0], silu_f(g1[1]) * u1[1]); w.w = pk2(silu_f(g1[2]) * u1[2], silu_f(g1[3]) * u1[3]);
                *(u32x4*)p = w; }
    } };
struct EpiResid { static constexpr bool PERM = true, AFTER_DRAIN = false; const float* src; float* dst; const float* modv; float gs;
    DI bool zero_after(const Unit&) const { return true; }
    DI void operator()(const f32x4 (&acc)[2][2][4][2], const Unit& u, int wr, int wc, int fr, int fq) const {
        asm volatile("" : "+v"(fr), "+v"(fq));
        const int row0 = u.pm * 256 + wr * 64 + fr; const float* mb = modv + (size_t)(u.pm >> 3) * NMODW;
        const int colb = u.pn * 256 + wc * 32 + 8 * fq;
        f32x4 mv[2][2];
#pragma unroll
        for (int bj = 0; bj < 2; ++bj)
#pragma unroll
            for (int n = 0; n < 2; ++n) mv[bj][n] = *(const f32x4*)(mb + colb + bj * 128 + 4 * n) * gs;
#pragma unroll
        for (int ai = 0; ai < 2; ++ai)
#pragma unroll
            for (int m = 0; m < 4; ++m) { const size_t o = (size_t)(row0 + ai * 128 + m * 16) * DM + colb;
                const f32x4 s00 = *(const f32x4*)(src + o), s01 = *(const f32x4*)(src + o + 4), s10 = *(const f32x4*)(src + o + 128), s11 = *(const f32x4*)(src + o + 132);
                *(f32x4*)(dst + o) = s00 + mv[0][0] * acc[ai][0][m][0]; *(f32x4*)(dst + o + 4) = s01 + mv[0][1] * acc[ai][0][m][1];
                *(f32x4*)(dst + o + 128) = s10 + mv[1][0] * acc[ai][1][m][0]; *(f32x4*)(dst + o + 132) = s11 + mv[1][1] * acc[ai][1][m][1]; }
    } };
struct EpiProj { static constexpr bool PERM = true, AFTER_DRAIN = false; unsigned char* ws;
    DI bool zero_after(const Unit&) const { return true; }
    DI void operator()(const f32x4 (&acc)[2][2][4][2], const Unit& u, int wr, int wc, int fr, int fq) const {
        asm volatile("" : "+v"(fr), "+v"(fq));
        const int pn = u.pn, row0 = u.pm * 256 + wr * 64 + fr;
        if (pn == 29) { float* dab = (float*)(ws + OFF_DAB);
            if (wc == 0 && fq < 2) {
#pragma unroll
                for (int ai = 0; ai < 2; ++ai)
#pragma unroll
                    for (int m = 0; m < 4; ++m)
#pragma unroll
                        for (int n = 0; n < 2; ++n) *(f32x4*)(dab + (size_t)(row0 + ai * 128 + m * 16) * 16 + 8 * fq + 4 * n) = acc[ai][0][m][n]; }
            return; }
        bf16_t* base; int ld, c0, act = 0;
        if (pn < 3) { base = (bf16_t*)(ws + OFF_AQKV); ld = 768; c0 = pn * 256; }
        else if (pn < 9) { base = (bf16_t*)(ws + OFF_DQKV); ld = 1536; c0 = (pn - 3) * 256; }
        else if (pn < 11) { base = (bf16_t*)(ws + OFF_DZ); ld = 512; c0 = (pn - 9) * 256; act = 1; }
        else if (pn < 17) { base = (bf16_t*)(ws + OFF_R); ld = 1536; c0 = (pn - 11) * 256; act = (pn >= 15) ? 1 : 0; }
        else { base = (bf16_t*)(ws + OFF_GATES); ld = 3072; c0 = (pn - 17) * 256; act = 2; }
        const int col0 = c0 + wc * 32 + 8 * fq;
#pragma unroll
        for (int ai = 0; ai < 2; ++ai)
#pragma unroll
            for (int m = 0; m < 4; ++m) { bf16_t* rowp = base + (size_t)(row0 + ai * 128 + m * 16) * ld + col0;
#pragma unroll
                for (int bj = 0; bj < 2; ++bj) { f32x4 v0 = acc[ai][bj][m][0], v1 = acc[ai][bj][m][1];
                    if (pn == 11 || pn == 12) {
                        const int row = row0 + ai * 128 + m * 16, cit = bj * 128 + wc * 32 + 8 * fq, hh = cit >> 6, d0 = cit & 63, pos = row & (SEQL - 1), ii = row & 63;
                        const float* tr = (const float*)(ws + OFF_TR) + ((size_t)pos * 32 + (d0 >> 1)) * 2; const f32x4 t0 = *(const f32x4*)tr, t1 = *(const f32x4*)(tr + 4);
                        const float lgh = logf(1.f - exp2f(-5.f - (float)hh)), sc = (pn == 11) ? expf(lgh * (float)(ii + 1)) : 0.125f * expf(lgh * (float)(63 - ii));
                        const f32x4 a = v0, bq = v1;
                        v0[0] = (a[0] * t0[0] - a[1] * t0[1]) * sc; v0[1] = (a[1] * t0[0] + a[0] * t0[1]) * sc; v0[2] = (a[2] * t0[2] - a[3] * t0[3]) * sc; v0[3] = (a[3] * t0[2] + a[2] * t0[3]) * sc;
                        v1[0] = (bq[0] * t1[0] - bq[1] * t1[1]) * sc; v1[1] = (bq[1] * t1[0] + bq[0] * t1[1]) * sc; v1[2] = (bq[2] * t1[2] - bq[3] * t1[3]) * sc; v1[3] = (bq[3] * t1[2] + bq[2] * t1[3]) * sc; }
                    if (act == 1) { for (int e = 0; e < 4; ++e) { v0[e] = silu_f(v0[e]); v1[e] = silu_f(v1[e]); } }
                    else if (act == 2) { for (int e = 0; e < 4; ++e) { v0[e] = sigm_f(v0[e]); v1[e] = sigm_f(v1[e]); } }
                    *(u32x4*)(rowp + bj * 128) = __builtin_bit_cast(u32x4, pack8(v0, v1)); } }
    } };
struct EpiMerge { static constexpr bool PERM = true, AFTER_DRAIN = false; const bf16_t* gates; bf16_t* merged;
    DI bool zero_after(const Unit& u) const { return (u.pn >> 2) == 2; }
    DI void operator()(f32x4 (&acc)[2][2][4][2], const Unit& u, int wr, int wc, int fr, int fq) const {
        asm volatile("" : "+v"(fr), "+v"(fq));
        const int b = u.pn >> 2, pm = u.pm & 63, pn = u.pn & 3, row0 = pm * 256 + wr * 64 + fr;
#pragma unroll
        for (int ai = 0; ai < 2; ++ai)
#pragma unroll
            for (int bj = 0; bj < 2; ++bj) { const int col0 = pn * 256 + bj * 128 + wc * 32 + 8 * fq;
                u32x4 gr[4], gnr[4];
#pragma unroll
                for (int m = 0; m < 4; ++m) { const size_t row = (size_t)(row0 + ai * 128 + m * 16); gr[m] = *(const u32x4*)(gates + row * 3072 + b * 1024 + col0);
                    gnr[m] = (b < 2) ? *(const u32x4*)(gates + row * 3072 + (b + 1) * 1024 + col0) : gr[m]; }
#pragma unroll
                for (int m = 0; m < 4; ++m) { const size_t row = (size_t)(row0 + ai * 128 + m * 16);
                    float g[8]; unpack8(gr[m], g);
                    f32x4& v0 = acc[ai][bj][m][0]; f32x4& v1 = acc[ai][bj][m][1];
                    if (b < 2) { float gn[8]; unpack8(gnr[m], gn);
#pragma unroll
                        for (int e = 0; e < 4; ++e) { v0[e] *= fmaxf(g[e], 1e-20f) * __builtin_amdgcn_rcpf(fmaxf(gn[e], 1e-20f)); v1[e] *= fmaxf(g[4 + e], 1e-20f) * __builtin_amdgcn_rcpf(fmaxf(gn[4 + e], 1e-20f)); } }
                    else { u32x4 w; w.x = pk2(v0[0] * fmaxf(g[0], 1e-20f), v0[1] * fmaxf(g[1], 1e-20f)); w.y = pk2(v0[2] * fmaxf(g[2], 1e-20f), v0[3] * fmaxf(g[3], 1e-20f));
                        w.z = pk2(v1[0] * fmaxf(g[4], 1e-20f), v1[1] * fmaxf(g[5], 1e-20f)); w.w = pk2(v1[2] * fmaxf(g[6], 1e-20f), v1[3] * fmaxf(g[7], 1e-20f));
                        *(u32x4*)(merged + row * DM + col0) = w; } } }
    } };
struct MergeOrder { int G, c;
    DI bool next(int i, Unit& u) const { const int T = c + G * (i / 3), b = i % 3; if (T >= 256) return false; u.pm = b * 64 + (T >> 2); u.pn = b * 4 + (T & 3); return true; }
    DI void a_ready(const Unit&) const {} DI void done(const Unit&) const {} };

DI float wave_sum(float v) {
#pragma unroll
    for (int o = 1; o < 64; o <<= 1) v += __shfl_xor(v, o);
    return v; }

DI void phase_mod(const Params& p, unsigned char* lds, int tid) {
    float* sc = (float*)lds; float* red = sc + 8192;
    const float* c = p.in[1]; float* MOD = (float*)(p.ws + OFF_MOD);
    for (int i = tid; i < 8192; i += 512) { const float v = c[i]; sc[i] = v / (1.f + expf(-v)); }
    __syncthreads();
    for (int grp = blockIdx.x; grp < 256; grp += gridDim.x) {
        const int cc = tid % 72, kp = tid / 72;
        const int n = grp * 72 + cc, l = n / NMODW, nn = n % NMODW;
        float a0 = 0, a1 = 0, a2 = 0, a3 = 0, a4 = 0, a5 = 0, a6 = 0, a7 = 0;
        if (kp < 7) {
            const float* w = p.in[2] + (size_t)l * DM * NMODW + nn;
            for (int kb = kp * 147; kb < kp * 147 + 147; kb += 21) {
                float wv[21];
#pragma unroll
                for (int q = 0; q < 21; ++q) { const int k = kb + q; wv[q] = (k < DM) ? w[(size_t)k * NMODW] : 0.f; }
#pragma unroll
                for (int q = 0; q < 21; ++q) { const int k = (kb + q < DM) ? kb + q : 0; const float x = wv[q];
                    a0 += sc[k] * x; a1 += sc[1024 + k] * x; a2 += sc[2048 + k] * x; a3 += sc[3072 + k] * x; a4 += sc[4096 + k] * x; a5 += sc[5120 + k] * x; a6 += sc[6144 + k] * x; a7 += sc[7168 + k] * x; }
            }
            red[(kp * 8 + 0) * 72 + cc] = a0; red[(kp * 8 + 1) * 72 + cc] = a1; red[(kp * 8 + 2) * 72 + cc] = a2; red[(kp * 8 + 3) * 72 + cc] = a3;
            red[(kp * 8 + 4) * 72 + cc] = a4; red[(kp * 8 + 5) * 72 + cc] = a5; red[(kp * 8 + 6) * 72 + cc] = a6; red[(kp * 8 + 7) * 72 + cc] = a7;
        }
        __syncthreads();
        for (int o = tid; o < 8 * 72; o += 512) { const int b = o / 72, c2 = o % 72; float s = 0.f;
#pragma unroll
            for (int q = 0; q < 7; ++q) s += red[(q * 8 + b) * 72 + c2];
            const int n2 = grp * 72 + c2, l2 = n2 / NMODW, nn2 = n2 % NMODW;
            MOD[(size_t)(l2 * 8 + b) * NMODW + nn2] = s + p.in[3][l2 * NMODW + nn2]; }
        __syncthreads();
    }
    const int gt = blockIdx.x * 512 + tid, NT = gridDim.x * 512;
    float* TA = (float*)(p.ws + OFF_TA); float* TR = (float*)(p.ws + OFF_TR);
    for (int idx = gt; idx < 2048 * 8; idx += NT) { const int pos = idx >> 3, pp = idx & 7;
        const float invf = exp2f(-18.931568569324174f * ((float)(2 * pp) * (1.f / 16.f))); float rev = (float)pos * invf * 0.15915494309189535f; rev -= rintf(rev);
        TA[idx * 2] = __builtin_amdgcn_cosf(rev); TA[idx * 2 + 1] = __builtin_amdgcn_sinf(rev); }
    for (int idx = gt; idx < 2048 * 32; idx += NT) { const int pos = idx >> 5, pp = idx & 31;
        const float ang = exp2f(-13.287712379549449f * ((float)pp * (1.f / 31.f))); float rev = (float)pos * ang * 0.15915494309189535f; rev -= rintf(rev);
        TR[idx * 2] = __builtin_amdgcn_cosf(rev); TR[idx * 2 + 1] = __builtin_amdgcn_sinf(rev); }
}

DI int dstrow(int mode, int n) {
    if (mode == 1) return (n < DFF) ? ((n >> 7) * 256 + (n & 127)) : (((n - DFF) >> 7) * 256 + 128 + ((n - DFF) & 127));
    if (mode == 2) return (n < 2304) ? n : ((n < 2320) ? (7424 + n - 2304) : (n - 16));
    return n; }
DI void conv_item(const float* W, int K, int N, bf16_t* WT, int mode, float* scr, int item, int lane) {
    const int nblk = (N + 31) / 32, kb = item / nblk, nb = item % nblk, k0 = 64 * kb, n0 = 32 * nb;
    const int nn = n0 + (lane & 31); const bool okn = nn < N;
    float wv[32];
#pragma unroll
    for (int i = 0; i < 32; ++i) { const int kk = 2 * i + (lane >> 5); wv[i] = okn ? W[(size_t)(k0 + kk) * N + nn] : 0.f; }
#pragma unroll
    for (int i = 0; i < 32; ++i) { const int kk = 2 * i + (lane >> 5); scr[kk * 33 + (lane & 31)] = wv[i]; }
    asm volatile("s_waitcnt lgkmcnt(0)" ::: "memory");
    const int c = lane & 7;
#pragma unroll
    for (int j = 0; j < 4; ++j) { const int n = (lane >> 3) + 8 * j; const float* s = scr + (8 * c) * 33 + n;
        u32x4 o; o.x = pk2(s[0 * 33], s[1 * 33]); o.y = pk2(s[2 * 33], s[3 * 33]); o.z = pk2(s[4 * 33], s[5 * 33]); o.w = pk2(s[6 * 33], s[7 * 33]);
        if (n0 + n < N) *(u32x4*)(WT + (size_t)dstrow(mode, n0 + n) * K + k0 + 8 * c) = o; }
    asm volatile("s_waitcnt lgkmcnt(0)" ::: "memory");
}
DI void modulate_rows(const float* x, const float* gain, const float* modl, int slot, bf16_t* U, int gw, int NGW, int lane) {
    constexpr int NR = 4;
    for (int m0 = gw; m0 < MT; m0 += NR * NGW) {
        int mr[NR]; f32x4 v[NR][4]; float s[NR];
#pragma unroll
        for (int q = 0; q < NR; ++q) { mr[q] = (m0 + q * NGW < MT) ? m0 + q * NGW : m0;
#pragma unroll
            for (int j = 0; j < 4; ++j) v[q][j] = ((const f32x4*)(x + (size_t)mr[q] * DM) + lane)[64 * j]; }
#pragma unroll
        for (int q = 0; q < NR; ++q) { float a = 0.f;
#pragma unroll
            for (int j = 0; j < 4; ++j) a += (v[q][j][0] * v[q][j][0] + v[q][j][1] * v[q][j][1]) + (v[q][j][2] * v[q][j][2] + v[q][j][3] * v[q][j][3]);
            s[q] = rsqrtf(wave_sum(a) * (1.f / DM) + EPSF); }
#pragma unroll
        for (int j = 0; j < 4; ++j) { const int d = 4 * lane + 256 * j; const f32x4 g = *(const f32x4*)(gain + d);
#pragma unroll
            for (int q = 0; q < NR; ++q) { const float* mb = modl + (size_t)(mr[q] >> 11) * NMODW + slot * 3 * DM;
                const f32x4 y = v[q][j] * s[q] * g * (*(const f32x4*)(mb + DM + d) + 1.f) + *(const f32x4*)(mb + d);
                ((unsigned long long*)(U + (size_t)mr[q] * DM) + lane)[64 * j] = (unsigned long long)pk2(y[0], y[1]) | ((unsigned long long)pk2(y[2], y[3]) << 32); } }
    }
}
DI void convert_ffn(const Params& p, int l, int which  , unsigned char* lds, int tid, int gw, int NGW) {
    const int lane = tid & 63, wave = tid >> 6; float* scr = (float*)(lds + wave * 16384);
    const float* w13 = p.in[which == 0 ? 5 : 19] + (size_t)l * DM * 2 * DFF; const float* w2 = p.in[which == 0 ? 6 : 20] + (size_t)l * DFF * DM;
    constexpr int I13 = 16 * 176, I2 = 44 * 32;
    for (int it = gw; it < I13 + I2; it += NGW) {
        if (it < I13) conv_item(w13, DM, 2 * DFF, (bf16_t*)(p.ws + OFF_W13T), 1, scr, it, lane);
        else conv_item(w2, DFF, DM, (bf16_t*)(p.ws + OFF_W2T), 0, scr, it - I13, lane); }
}
DI void convert_mix(const Params& p, int l, unsigned char* lds, int tid, int gw, int NGW) {
    unsigned zu = 0u; asm volatile("" : "+v"(zu));
    const int lane = tid & 63, wave = tid >> 6; float* scr = (float*)(lds + wave * 16384);
    const float* win = p.in[8] + (size_t)l * DM * 7440; const float* wb = p.in[16] + (size_t)l * 3 * 512 * DM; const float* wo = p.in[17] + (size_t)l * DM * DM;
    constexpr int IIN = 16 * 233, IB = 8 * 32, IO = 16 * 32;
    for (int it = gw; it < IIN + 3 * IB + IO; it += NGW) { int r = it;
        if (r < IIN) { conv_item(win, DM, 7440, (bf16_t*)(p.ws + OFF_WINT), 2, scr, r, lane); continue; } r -= IIN;
        if (r < 3 * IB) { const int g = r / IB; conv_item(wb + (size_t)g * 512 * DM, 512, DM, (bf16_t*)(p.ws + OFF_WBT) + (size_t)g * DM * 512, 0, scr, r % IB, lane); continue; } r -= 3 * IB;
        conv_item(wo, DM, DM, (bf16_t*)(p.ws + OFF_WOT), 0, scr, r, lane); }
    u32x4* z = (u32x4*)(p.ws + OFF_WINT + (size_t)7440 * DM * 2);
    for (int i = gw * 64 + lane; i < 240 * DM * 2 / 16; i += NGW * 64) z[i] = (u32x4){zu, zu, zu, zu};
}
DI void phase_prep(const Params& p, int l, int which  , const float* xsrc, unsigned char* lds, int tid, bool do_conv) {
    const int lane = tid & 63, wave = tid >> 6, gw = blockIdx.x * 8 + wave, NGW = gridDim.x * 8;
    if (do_conv) { if (which == 1) convert_mix(p, l, lds, tid, gw, NGW); else convert_ffn(p, l, which, lds, tid, gw, NGW); }
    const float* gain = p.in[which == 0 ? 4 : (which == 1 ? 7 : 18)] + l * DM;
    modulate_rows(xsrc, gain, (const float*)(p.ws + OFF_MOD) + (size_t)l * 8 * NMODW, which, (bf16_t*)(p.ws + OFF_U), gw, NGW, lane);
}
constexpr int PREP_CHUNK_BYTES = 40960;
DI void dn_prep_fetch(const Params& p, int item, int tid, u32x4 (&pre)[12]) {
    const int h = item & 7, n = (item >> 3) & 31, b = item >> 8, i = tid >> 3, d0 = (tid & 7) * 8;
    const bf16_t* DQKV = (const bf16_t*)(p.ws + OFF_DQKV);
#pragma unroll
    for (int mat = 0; mat < 3; ++mat)
#pragma unroll
        for (int j = 0; j < 4; ++j) { int t = n * 64 + i - 3 + j; t = t < 0 ? 0 : t; pre[mat * 4 + j] = *(const u32x4*)(DQKV + (size_t)(b * SEQL + t) * 1536 + mat * 512 + h * 64 + d0); }
}
DI void dn_prep_item(const Params& p, int l, int item, int next_item, u32x4 (&pre)[12], unsigned char* lds, int tid) {
    float zz = 0.f; asm volatile("" : "+v"(zz));
    const int h = item & 7, n = (item >> 3) & 31, b = item >> 8, lane = tid & 63;
    float* Qs = (float*)lds; float* Ks = Qs + 4160; float* Vs = Ks + 4160; float* Ls = Vs + 4160; float* AIs = Ls + 4096; float* XS = AIs + 4096;
    float* Gs = XS + 64 * 129; float* BETAs = Gs + 64; float* EGs = BETAs + 64;
    bf16_t* KH = (bf16_t*)(EGs + 64); bf16_t* KL = KH + 64 * 72; bf16_t* QH = KL + 64 * 72; bf16_t* QL = QH + 64 * 72;
    const float* DAB = (const float*)(p.ws + OFF_DAB);
    const float* cw = p.in[12] + (size_t)l * 4 * 1536;
    float da_raw = 0.f, db_raw = 0.f, dtb = 0.f, alog = 0.f;
    if (tid < 64) { const size_t tok = (size_t)b * SEQL + n * 64 + tid; da_raw = DAB[tok * 16 + h]; db_raw = DAB[tok * 16 + 8 + h]; dtb = p.in[14][l * 8 + h]; alog = p.in[13][l * 8 + h]; }
    {
        const int i = tid >> 3, d0 = (tid & 7) * 8;
#pragma unroll
        for (int mat = 0; mat < 3; ++mat) { const int col = mat * 512 + h * 64 + d0; float a[8];
#pragma unroll
            for (int e = 0; e < 8; ++e) a[e] = 0.f;
#pragma unroll
            for (int j = 0; j < 4; ++j) { const int t = n * 64 + i - 3 + j;
                if (t >= 0) { float xv[8]; unpack8(pre[mat * 4 + j], xv);
                    const f32x4 w0 = *(const f32x4*)(cw + j * 1536 + col), w1 = *(const f32x4*)(cw + j * 1536 + col + 4);
#pragma unroll
                    for (int e = 0; e < 4; ++e) { a[e] += w0[e] * xv[e]; a[4 + e] += w1[e] * xv[4 + e]; } } }
            float ss = 0.f;
#pragma unroll
            for (int e = 0; e < 8; ++e) { a[e] = silu_f(a[e]); ss += a[e] * a[e]; }
            float sc = 1.f;
            if (mat < 2) { ss += __shfl_xor(ss, 1); ss += __shfl_xor(ss, 2); ss += __shfl_xor(ss, 4); sc = rsqrtf(ss + EPSF) * (mat == 0 ? 0.125f : 1.f); }
            float* dst = (mat == 0 ? Qs : (mat == 1 ? Ks : Vs)) + i * 65 + d0;
#pragma unroll
            for (int e = 0; e < 8; ++e) { a[e] *= sc; dst[e] = a[e]; }
            if (mat < 2) { float hf[8], lo[8]; u32x4 wh, wl;
                wh.x = pk2(a[0], a[1]); wh.y = pk2(a[2], a[3]); wh.z = pk2(a[4], a[5]); wh.w = pk2(a[6], a[7]); unpack8(wh, hf);
#pragma unroll
                for (int e = 0; e < 8; ++e) lo[e] = a[e] - hf[e];
                wl.x = pk2(lo[0], lo[1]); wl.y = pk2(lo[2], lo[3]); wl.z = pk2(lo[4], lo[5]); wl.w = pk2(lo[6], lo[7]);
                *(u32x4*)((mat == 0 ? QH : KH) + i * 72 + d0) = wh; *(u32x4*)((mat == 0 ? QL : KL) + i * 72 + d0) = wl; } }
        { f32x4* z = (f32x4*)AIs + tid * 2; z[0] = (f32x4){zz, zz, zz, zz}; z[1] = (f32x4){zz, zz, zz, zz}; }
    }
    if (tid < 64) {
        const float a = da_raw + dtb, bb = db_raw;
        const float sp = (a > 20.f) ? a : ((a < -15.f) ? expf(a) : logf(1.f + expf(a)));
        float x = -expf(alog) * sp;
#pragma unroll
        for (int o = 1; o < 64; o <<= 1) { const float v = __shfl_up(x, o); if (lane >= o) x += v; }
        Gs[tid] = x; BETAs[tid] = 1.f / (1.f + expf(-bb)); EGs[tid] = expf(x);
    }
    __syncthreads();
    {
        const int wv = tid >> 6, c = lane & 15, g = lane >> 4;
        for (int t = wv; t < 20; t += 8) { const int isq = t >= 10, tt = isq ? t - 10 : t, it = (tt >= 6) ? 3 : ((tt >= 3) ? 2 : ((tt >= 1) ? 1 : 0)), jt = tt - it * (it + 1) / 2;
            const bf16_t* XHp = (isq ? QH : KH) + (16 * it + c) * 72 + 8 * g; const bf16_t* XLp = (isq ? QL : KL) + (16 * it + c) * 72 + 8 * g;
            const bf16_t* KHp = KH + (16 * jt + c) * 72 + 8 * g; const bf16_t* KLp = KL + (16 * jt + c) * 72 + 8 * g;
            f32x4 acc = (f32x4){zz, zz, zz, zz};
#pragma unroll
            for (int s = 0; s < 2; ++s) { const bf16x8 xh = *(const bf16x8*)(XHp + 32 * s), xl = *(const bf16x8*)(XLp + 32 * s), kh = *(const bf16x8*)(KHp + 32 * s), kl = *(const bf16x8*)(KLp + 32 * s);
                acc = MFMA16(xl, kh, acc); acc = MFMA16(xh, kl, acc); acc = MFMA16(xh, kh, acc); }
            const int jj = 16 * jt + c; const float gj = Gs[jj];
#pragma unroll
            for (int rr = 0; rr < 4; ++rr) { const int ii = 16 * it + 4 * g + rr; const float dec = (jj <= ii) ? expf(Gs[ii] - gj) : 0.f;
                if (isq) AIs[ii * 64 + jj] = (jj <= ii) ? acc[rr] * dec : 0.f; else Ls[ii * 64 + jj] = (jj < ii) ? BETAs[ii] * acc[rr] * dec : 0.f; } }
    }
    __syncthreads();
    {
        const int wv = tid >> 6; float* Zs = (float*)(QL + 64 * 72);
        if (wv < 5) {
            const int half = (wv >= 2) ? 1 : 0, c = (wv < 2) ? tid : ((wv < 4) ? tid - 128 : (lane & 31)), r0 = 32 * half;
            const float* Lb = Ls + r0 * 64 + r0;
            float x[32];
            if (wv < 4) {
#pragma unroll
                for (int i = 0; i < 32; ++i) x[i] = (c < 64) ? BETAs[r0 + i] * Vs[(r0 + i) * 65 + c] : BETAs[r0 + i] * Ks[(r0 + i) * 65 + c - 64] * EGs[r0 + i];
            } else {
#pragma unroll
                for (int i = 0; i < 32; ++i) x[i] = Ls[(32 + i) * 64 + c];
            }
            f32x4 cur[8], nxt[8];
            cur[0] = *(const f32x4*)(Lb + 64);
#pragma unroll
            for (int i = 1; i < 32; ++i) {
                if (i < 31) {
#pragma unroll
                    for (int q = 0; q < 8; ++q) if (4 * q < i + 1) nxt[q] = *(const f32x4*)(Lb + (i + 1) * 64 + 4 * q);
                }
                float a0 = x[i], a1 = 0.f, a2 = 0.f, a3 = 0.f;
#pragma unroll
                for (int j = 0; j < i; ++j) { const float lv = cur[j >> 2][j & 3];
                    if ((j & 3) == 0) a0 -= lv * x[j]; else if ((j & 3) == 1) a1 -= lv * x[j]; else if ((j & 3) == 2) a2 -= lv * x[j]; else a3 -= lv * x[j]; }
                x[i] = (a0 + a1) + (a2 + a3);
#pragma unroll
                for (int q = 0; q < 8; ++q) cur[q] = nxt[q];
            }
            if (wv < 4) {
#pragma unroll
                for (int i = 0; i < 32; ++i) XS[(r0 + i) * 129 + c] = x[i];
            } else if (lane < 32) {
#pragma unroll
                for (int i = 0; i < 32; ++i) Zs[i * 33 + c] = x[i];
            }
        } else {
            const int chunk_ = (b * 8 + h) * 32 + n; unsigned char* base_ = p.ws + OFF_U + (size_t)chunk_ * PREP_CHUNK_BYTES;
            const int r = lane & 15, g = lane >> 4; const float g63 = Gs[63];
            for (int q = wv - 5; q < 24; q += 3) { const int mat = q >> 3, f = q & 7, m = f >> 1, s = f & 1, row = 16 * m + r, c0 = 32 * s + 4 * g, c1 = c0 + 16;
                float v[8];
                if (mat == 0) { const float eg = EGs[row]; const float* a = Qs + row * 65;
#pragma unroll
                    for (int e = 0; e < 4; ++e) { v[e] = a[c0 + e] * eg; v[4 + e] = a[c1 + e] * eg; } }
                else if (mat == 1) { const float* a = AIs + row * 64;
#pragma unroll
                    for (int e = 0; e < 4; ++e) { v[e] = a[c0 + e]; v[4 + e] = a[c1 + e]; } }
                else {
#pragma unroll
                    for (int e = 0; e < 4; ++e) { v[e] = Ks[(c0 + e) * 65 + row] * expf(g63 - Gs[c0 + e]); v[4 + e] = Ks[(c1 + e) * 65 + row] * expf(g63 - Gs[c1 + e]); } }
                u32x4 w; w.x = pk2(v[0], v[1]); w.y = pk2(v[2], v[3]); w.z = pk2(v[4], v[5]); w.w = pk2(v[6], v[7]);
                *(u32x4*)(base_ + 8192 * (mat + 1) + (size_t)(f * 64 + lane) * 16) = w; }
        }
        __syncthreads();
        {
            const int c = tid & 127, rg = tid >> 7;
            float xt[32];
#pragma unroll
            for (int k = 0; k < 32; ++k) xt[k] = XS[k * 129 + c];
#pragma unroll
            for (int ii = 0; ii < 8; ++ii) { const int i = rg * 8 + ii; float a0 = XS[(32 + i) * 129 + c], a1 = 0.f;
#pragma unroll
                for (int k = 0; k < 32; k += 2) { a0 -= Zs[i * 33 + k] * xt[k]; a1 -= Zs[i * 33 + k + 1] * xt[k + 1]; }
                XS[(32 + i) * 129 + c] = a0 + a1; }
        }
    }
    __syncthreads();
    dn_prep_fetch(p, next_item < 2048 ? next_item : item, tid, pre);
    {
        const int chunk = (b * 8 + h) * 32 + n; unsigned char* base = p.ws + OFF_U + (size_t)chunk * PREP_CHUNK_BYTES;
        const int f = tid >> 6, m = f >> 1, s = f & 1, r = lane & 15, g = lane >> 4, row = 16 * m + r, c0 = 32 * s + 4 * g, c1 = c0 + 16;
        u32x4 w;
        { const float* a = XS + row * 129 + 64; w.x = pk2(a[c0], a[c0 + 1]); w.y = pk2(a[c0 + 2], a[c0 + 3]); w.z = pk2(a[c1], a[c1 + 1]); w.w = pk2(a[c1 + 2], a[c1 + 3]); *(u32x4*)(base + (size_t)tid * 16) = w; }
#pragma unroll
        for (int q = 0; q < 2; ++q) { const int idx = tid * 2 + q, wm = idx >> 6, ln = idx & 63, vv = 16 * (wm >> 2) + (ln & 15), r0 = 16 * (wm & 3) + 4 * (ln >> 4);
            u32x2 o; o.x = pk2(XS[r0 * 129 + vv], XS[(r0 + 1) * 129 + vv]); o.y = pk2(XS[(r0 + 2) * 129 + vv], XS[(r0 + 3) * 129 + vv]); *(u32x2*)(base + 32768 + (size_t)idx * 8) = o; }
        if (tid == 0) ((float*)(p.ws + OFF_CD))[chunk] = EGs[63];
    }
    __syncthreads();
}

DI void dn_scan_wg(const Params& p, int l, int bh, unsigned char* lds, int tid) {
    float zz = 0.f; unsigned zu = 0u; asm volatile("" : "+v"(zz), "+v"(zu));
    const int lane = tid & 63, w = tid >> 6, b = bh >> 3, h = bh & 7, c = lane & 15, g = lane >> 4;
    unsigned char* OX = lds + 2 * PREP_CHUNK_BYTES;
    const bf16_t* DZ = (const bf16_t*)(p.ws + OFF_DZ); bf16_t* BRB = (bf16_t*)(p.ws + OFF_DQKV) + (size_t)MT * 512;
    const unsigned char* gsrc = p.ws + OFF_U + (size_t)(bh * 32) * PREP_CHUNK_BYTES;
    const float* CDp = (const float*)(p.ws + OFF_CD) + bh * 32;
    {
        u32x4 t0[5];
#pragma unroll
        for (int k = 0; k < 5; ++k) t0[k] = *(const u32x4*)(gsrc + (size_t)tid * 16 + k * 8192);
#pragma unroll
        for (int k = 0; k < 5; ++k) *(u32x4*)(lds + tid * 16 + k * 8192) = t0[k];
    }
    const int st = (w & 3) * 64 + lane;
    u32x4 stA[10], stB[10]; bf16_t gzA[4][4], gzB[4][4]; float onv[4];
    f32x4 S[4];
#pragma unroll
    for (int i = 0; i < 4; ++i) S[i] = (f32x4){zz, zz, zz, zz};
    if (w >= 4) {
#pragma unroll
        for (int k = 0; k < 10; ++k) { stA[k] = *(const u32x4*)(gsrc + (size_t)PREP_CHUNK_BYTES + (size_t)st * 16 + k * 4096); stB[k] = stA[k]; }
#pragma unroll
        for (int q = 0; q < 4; ++q) onv[q] = p.in[15][l * 64 + 16 * q + c];
#pragma unroll
        for (int q = 0; q < 4; ++q)
#pragma unroll
            for (int r = 0; r < 4; ++r) { gzA[q][r] = 0; gzB[q][r] = 0; }
    }
    __syncthreads();
#define DN_FINAL(nn, GZ) do { const unsigned char* ox = OX + ((nn) & 1) * 16384; const int x = w - 4; f32x4 o[4]; float q0 = 0.f, q1 = 0.f, q2 = 0.f, q3 = 0.f; \
        _Pragma("unroll") for (int q = 0; q < 4; ++q) { o[q] = *(const f32x4*)(ox + ((q * 4 + x) * 64 + lane) * 16); q0 += o[q][0] * o[q][0]; q1 += o[q][1] * o[q][1]; q2 += o[q][2] * o[q][2]; q3 += o[q][3] * o[q][3]; } \
        ROW_SUM16(q0); ROW_SUM16(q1); ROW_SUM16(q2); ROW_SUM16(q3); \
        const float rs[4] = {rsqrtf(q0 * (1.f / 64.f) + EPSF), rsqrtf(q1 * (1.f / 64.f) + EPSF), rsqrtf(q2 * (1.f / 64.f) + EPSF), rsqrtf(q3 * (1.f / 64.f) + EPSF)}; \
        _Pragma("unroll") for (int q = 0; q < 4; ++q) _Pragma("unroll") for (int r = 0; r < 4; ++r) { \
            const size_t tok = (size_t)b * SEQL + (nn) * 64 + 16 * x + 4 * g + r; \
            BRB[tok * 512 + h * 64 + 16 * q + c] = (bf16_t)f2bf(o[q][r] * rs[r] * onv[q] * bf1(GZ[q][r])); } } while (0)
#define DN_STEP(n, X, Y, GZC, GZN) do { \
        if (w < 4) { \
            const unsigned char* buf = lds + ((n) & 1) * PREP_CHUNK_BYTES; \
            const float cd = CDp[(n)]; \
            bf16x8 Sb[2]; Sb[0] = pack8(S[0], S[1]); Sb[1] = pack8(S[2], S[3]); \
            f32x4 vn[4]; \
            _Pragma("unroll") for (int m = 0; m < 4; ++m) { f32x4 t = (f32x4){zz, zz, zz, zz}; \
                t = MFMA16(*(const bf16x8*)(buf + ((m * 2 + 0) * 64 + lane) * 16), Sb[0], t); t = MFMA16(*(const bf16x8*)(buf + ((m * 2 + 1) * 64 + lane) * 16), Sb[1], t); \
                const u32x2 uu = *(const u32x2*)(buf + 32768 + ((w * 4 + m) * 64 + lane) * 8); \
                vn[m] = (f32x4){bflo(uu.x), bfhi(uu.x), bflo(uu.y), bfhi(uu.y)} - t; } \
            bf16x8 vb[2]; vb[0] = pack8(vn[0], vn[1]); vb[1] = pack8(vn[2], vn[3]); \
            _Pragma("unroll") for (int kt = 0; kt < 4; ++kt) { f32x4 t = S[kt] * cd; \
                t = MFMA16(*(const bf16x8*)(buf + 24576 + ((kt * 2 + 0) * 64 + lane) * 16), vb[0], t); t = MFMA16(*(const bf16x8*)(buf + 24576 + ((kt * 2 + 1) * 64 + lane) * 16), vb[1], t); S[kt] = t; } \
            _Pragma("unroll") for (int m = 0; m < 4; ++m) { f32x4 t = (f32x4){zz, zz, zz, zz}; \
                t = MFMA16(*(const bf16x8*)(buf + 8192 + ((m * 2 + 0) * 64 + lane) * 16), Sb[0], t); t = MFMA16(*(const bf16x8*)(buf + 8192 + ((m * 2 + 1) * 64 + lane) * 16), Sb[1], t); \
                t = MFMA16(*(const bf16x8*)(buf + 16384 + ((m * 2 + 0) * 64 + lane) * 16), vb[0], t); t = MFMA16(*(const bf16x8*)(buf + 16384 + ((m * 2 + 1) * 64 + lane) * 16), vb[1], t); \
                *(f32x4*)(OX + ((n) & 1) * 16384 + ((w * 4 + m) * 64 + lane) * 16) = t; } \
        } else { \
            _Pragma("unroll") for (int q = 0; q < 4; ++q) _Pragma("unroll") for (int r = 0; r < 4; ++r) GZN[q][r] = DZ[((size_t)b * SEQL + (n) * 64 + 16 * (w - 4) + 4 * g + r) * 512 + h * 64 + 16 * q + c]; \
            if ((n) + 2 < 32) { _Pragma("unroll") for (int k = 0; k < 10; ++k) Y[k] = *(const u32x4*)(gsrc + (size_t)((n) + 2) * PREP_CHUNK_BYTES + (size_t)st * 16 + k * 4096); } \
            if ((n) >= 1) DN_FINAL((n) - 1, GZC); \
            if ((n) + 1 < 32) { _Pragma("unroll") for (int k = 0; k < 10; ++k) *(u32x4*)(lds + (((n) + 1) & 1) * PREP_CHUNK_BYTES + st * 16 + k * 4096) = X[k]; } \
        } \
        __syncthreads(); } while (0)
    for (int n = 0; n < 32; n += 2) { DN_STEP(n, stA, stB, gzB, gzA); DN_STEP(n + 1, stB, stA, gzA, gzB); }
    if (w >= 4) DN_FINAL(31, gzB);
#undef DN_STEP
#undef DN_FINAL
}

typedef short v4i16_t __attribute__((ext_vector_type(4)));
DI u32x2 trread(const bf16_t* p) { return __builtin_bit_cast(u32x2, __builtin_amdgcn_ds_read_tr16_b64_v4i16((__attribute__((address_space(3))) v4i16_t*)p)); }
DI void ret_scan_wg(const Params& p, int l, int bhi, unsigned char* lds, int tid) {
    const int bh = bhi >> 1, ih = bhi & 1;
    float zz = 0.f; unsigned zu = 0u; asm volatile("" : "+v"(zz), "+v"(zu));
    const int lane = tid & 63, w = tid >> 6, b = bh >> 2, h = bh & 3;
    constexpr int RB = 35840;
    float* red = (float*)(lds + 3 * RB);
    float* OT = (float*)(lds + 3 * RB + 4096);
    unsigned char* PA = lds + 3 * RB + 4096 + 33792;
    const int tokrow = tid >> 4, cp = tid & 15;
    const bf16_t* R = (const bf16_t*)(p.ws + OFF_R); bf16_t* BRC = (bf16_t*)(p.ws + OFF_DQKV) + (size_t)2 * MT * 512;
    const float lg = logf(1.f - exp2f(-5.f - (float)h)), cfac = expf(-64.f * lg), cdec = expf(64.f * lg);
    f32x4 S[4], out[2];
#pragma unroll
    for (int i = 0; i < 4; ++i) S[i] = (f32x4){zz, zz, zz, zz};
    out[0] = S[0]; out[1] = S[0];
    const int itA = ih ? 1 : 0, itB = ih ? 2 : 3;
    const int li = tid >> 3, ld0 = (tid & 7) * 8, lc0 = (tid & 7) * 16;
    const bf16_t* gsrc = R + ((size_t)b * SEQL + li) * 1536;
#define RET_LOAD(X, nn) do { const bf16_t* r_ = gsrc + (size_t)(nn) * 64 * 1536; X[0] = *(const u32x4*)(r_ + h * 64 + ld0); X[1] = *(const u32x4*)(r_ + 256 + h * 64 + ld0); \
        X[2] = *(const u32x4*)(r_ + 512 + h * 128 + lc0); X[3] = *(const u32x4*)(r_ + 512 + h * 128 + lc0 + 8); } while (0)
#define RET_STORE(X, bufi) do { bf16_t* B_ = (bf16_t*)(lds + (bufi) * RB); *(u32x4*)(B_ + li * 72 + ld0) = X[0]; *(u32x4*)(B_ + 64 * 72 + li * 72 + ld0) = X[1]; \
        *(u32x4*)(B_ + 128 * 72 + li * 136 + lc0) = X[2]; *(u32x4*)(B_ + 128 * 72 + li * 136 + lc0 + 8) = X[3]; } while (0)
    const int c_ = lane & 15, g_ = lane >> 4;
#define RET_PTILE(nn) do { const int e_ = w >> 2, jt_ = w & 3, it_ = e_ ? itB : itA; \
        const bf16_t* QDp = (const bf16_t*)(lds + ((nn) % 3) * RB); const bf16_t* KTp = QDp + 64 * 72; \
        f32x4 t = (f32x4){zz, zz, zz, zz}; \
        if (jt_ <= it_) { const bf16x8 q0 = *(const bf16x8*)(QDp + (16 * it_ + c_) * 72 + 8 * g_), q1 = *(const bf16x8*)(QDp + (16 * it_ + c_) * 72 + 32 + 8 * g_); \
            const bf16x8 k0 = *(const bf16x8*)(KTp + (16 * jt_ + c_) * 72 + 8 * g_), k1 = *(const bf16x8*)(KTp + (16 * jt_ + c_) * 72 + 32 + 8 * g_); \
            t = MFMA16(k0, q0, t); t = MFMA16(k1, q1, t); t = t * cfac; \
            if (jt_ == it_) { _Pragma("unroll") for (int r = 0; r < 4; ++r) t[r] = (4 * g_ + r <= c_) ? t[r] : 0.f; } } \
        u32x2 hv; hv.x = pk2(t[0], t[1]); hv.y = pk2(t[2], t[3]); \
        *(u32x2*)(PA + ((nn) & 1) * 4096 + ((e_ * 2 + (jt_ >> 1)) * 64 + lane) * 16 + (jt_ & 1) * 8) = hv; } while (0)
    u32x4 stA[4], stB[4];
    RET_LOAD(stA, 0); RET_LOAD(stB, 1); RET_STORE(stA, 0); RET_STORE(stB, 1); RET_LOAD(stA, 2);
    __syncthreads();
    RET_PTILE(0);
    __syncthreads();
#define RET_STEP(n, X, Y) do { \
        int c = c_, g = g_; asm volatile("" : "+v"(c), "+v"(g)); \
        const bf16_t* QD = (const bf16_t*)(lds + ((n) % 3) * RB); const bf16_t* KT = QD + 64 * 72; const bf16_t* VS = KT + 64 * 72; \
        const size_t tokp = (size_t)b * SEQL + ((n) - 1) * 64 + 16 * ((tokrow >> 4) ? itB : itA) + (tokrow & 15); \
        u32x4 gq = (u32x4){zu, zu, zu, zu}; if ((n) >= 1) gq = *(const u32x4*)(R + tokp * 1536 + 1024 + h * 128 + 8 * cp); \
        if ((n) + 3 < 32) RET_LOAD(Y, (n) + 3); \
        if ((n) + 1 < 32) RET_PTILE((n) + 1); \
        bf16x8 Vb[2], Sb[2]; \
        const int tq = c >> 2, tp = c & 3; \
        _Pragma("unroll") for (int s = 0; s < 2; ++s) { const bf16_t* vp = VS + (32 * s + 4 * g + tq) * 136 + 16 * w + 4 * tp; Vb[s] = cat8(trread(vp), trread(vp + 16 * 136)); } \
        Sb[0] = pack8(S[0], S[1]); Sb[1] = pack8(S[2], S[3]); \
        _Pragma("unroll") for (int e = 0; e < 2; ++e) { const int it = e ? itB : itA; \
            const unsigned char* pap = PA + ((n) & 1) * 4096 + (e * 2 * 64 + lane) * 16; \
            f32x4 o = (f32x4){zz, zz, zz, zz}; \
            o = MFMA16(*(const bf16x8*)pap, Vb[0], o); \
            if (it >= 2) o = MFMA16(*(const bf16x8*)(pap + 1024), Vb[1], o); \
            _Pragma("unroll") for (int s = 0; s < 2; ++s) { const bf16_t* qp = QD + (16 * it + c) * 72 + 32 * s + 4 * g; o = MFMA16(cat8(*(const u32x2*)qp, *(const u32x2*)(qp + 16)), Sb[s], o); } \
            out[e] = o; \
        } \
        _Pragma("unroll") for (int dt = 0; dt < 4; ++dt) { f32x4 t = S[dt] * cdec; \
            _Pragma("unroll") for (int s = 0; s < 2; ++s) { const bf16_t* kp = KT + (32 * s + 4 * g + tq) * 72 + 16 * dt + 4 * tp; t = MFMA16(cat8(trread(kp), trread(kp + 16 * 72)), Vb[s], t); } \
            S[dt] = t; } \
        float* rb = red + ((n) & 1) * 512; \
        _Pragma("unroll") for (int m = 0; m < 2; ++m) _Pragma("unroll") for (int r = 0; r < 4; ++r) { float q = out[m][r] * out[m][r]; ROW_SUM16(q); \
            if (c == 0) rb[w * 64 + 16 * m + 4 * g + r] = q; } \
        if ((n) + 2 < 32) RET_STORE(X, ((n) + 2) % 3); \
        __syncthreads(); \
        _Pragma("unroll") for (int m = 0; m < 2; ++m) { f32x4 tot = *(const f32x4*)(rb + 16 * m + 4 * g); \
            _Pragma("unroll") for (int q = 1; q < 8; ++q) tot = tot + *(const f32x4*)(rb + q * 64 + 16 * m + 4 * g); \
            _Pragma("unroll") for (int r = 0; r < 4; ++r) OT[((n) & 1) * 4224 + (16 * m + 4 * g + r) * 132 + 16 * w + c] = out[m][r] * rsqrtf(tot[r] * (1.f / 128.f) + EPSF); } \
        if ((n) >= 1) { const float* op = OT + (((n) - 1) & 1) * 4224 + tokrow * 132 + 8 * cp; const f32x4 a0 = *(const f32x4*)op, a1 = *(const f32x4*)(op + 4); float gg[8]; unpack8(gq, gg); \
            u32x4 wo; wo.x = pk2(a0[0] * gg[0], a0[1] * gg[1]); wo.y = pk2(a0[2] * gg[2], a0[3] * gg[3]); wo.z = pk2(a1[0] * gg[4], a1[1] * gg[5]); wo.w = pk2(a1[2] * gg[6], a1[3] * gg[7]); \
            *(u32x4*)(BRC + tokp * 512 + h * 128 + 8 * cp) = wo; } \
    } while (0)
    for (int n = 0; n < 32; n += 2) { RET_STEP(n, stA, stB); RET_STEP(n + 1, stB, stA); }
    __syncthreads();
    {
        const size_t tokp = (size_t)b * SEQL + 31 * 64 + 16 * ((tokrow >> 4) ? itB : itA) + (tokrow & 15);
        const u32x4 gq = *(const u32x4*)(R + tokp * 1536 + 1024 + h * 128 + 8 * cp);
        const float* op = OT + 4224 + tokrow * 132 + 8 * cp; const f32x4 a0 = *(const f32x4*)op, a1 = *(const f32x4*)(op + 4); float gg[8]; unpack8(gq, gg);
        u32x4 wo; wo.x = pk2(a0[0] * gg[0], a0[1] * gg[1]); wo.y = pk2(a0[2] * gg[2], a0[3] * gg[3]); wo.z = pk2(a1[0] * gg[4], a1[1] * gg[5]); wo.w = pk2(a1[2] * gg[6], a1[3] * gg[7]);
        *(u32x4*)(BRC + tokp * 512 + h * 128 + 8 * cp) = wo;
    }
#undef RET_STEP
#undef RET_PTILE
#undef RET_LOAD
#undef RET_STORE
}

DI void attn_item(const Params& p, int l, int item, unsigned char* lds, int tid) {
    float zz = 0.f; unsigned zu = 0u; asm volatile("" : "+v"(zz), "+v"(zu));
    const int kvh = item & 1, nb = (item >> 1) & 15, b = item >> 5, lane = tid & 63, wave = tid >> 6, c = lane & 15, g = lane >> 4;
    bf16_t* KS = (bf16_t*)lds; bf16_t* VT = KS + 256 * 72;
    const bf16_t* A = (const bf16_t*)(p.ws + OFF_AQKV); const float* TA = (const float*)(p.ws + OFF_TA); bf16_t* BRA = (bf16_t*)(p.ws + OFF_DQKV);
    const float* qn = p.in[9] + l * 64; const float* kn = p.in[10] + l * 64;
    {
        const int d0 = (tid & 7) * 8;
#pragma unroll
        for (int pz = 0; pz < 4; ++pz) { const int jj = pz * 64 + (tid >> 3), pos = (nb - 1) * 128 + jj;
            float k[8]; u32x4 vv = (u32x4){zu, zu, zu, zu};
            if (pos >= 0) { const size_t tok = (size_t)b * SEQL + pos; unpack8(*(const u32x4*)(A + tok * 768 + 512 + kvh * 64 + d0), k); vv = *(const u32x4*)(A + tok * 768 + 640 + kvh * 64 + d0); }
            else { for (int e = 0; e < 8; ++e) k[e] = 0.f; }
            float ss = 0.f;
#pragma unroll
            for (int e = 0; e < 8; ++e) ss += k[e] * k[e];
            ss += __shfl_xor(ss, 1); ss += __shfl_xor(ss, 2); ss += __shfl_xor(ss, 4);
            const float r = rsqrtf(ss * (1.f / 64.f) + EPSF);
            float part[8];
#pragma unroll
            for (int e = 0; e < 8; ++e) { k[e] = k[e] * r * kn[d0 + e]; part[e] = __shfl_xor(k[e], 1); }
            if (d0 < 16 && pos >= 0) {
#pragma unroll
                for (int e = 0; e < 8; ++e) { const float cs = TA[(pos * 8 + e) * 2], sn = TA[(pos * 8 + e) * 2 + 1];
                    k[e] = (d0 == 0) ? (k[e] * cs - part[e] * sn) : (k[e] * cs + part[e] * sn); } }
            u32x4 wk; wk.x = pk2(k[0], k[1]); wk.y = pk2(k[2], k[3]); wk.z = pk2(k[4], k[5]); wk.w = pk2(k[6], k[7]);
            *(u32x4*)(KS + jj * 72 + d0) = wk;
            const unsigned vw[4] = {vv.x, vv.y, vv.z, vv.w};
#pragma unroll
            for (int e = 0; e < 4; ++e) { VT[(d0 + 2 * e) * 264 + jj] = (bf16_t)(vw[e] & 0xffffu); VT[(d0 + 2 * e + 1) * 264 + jj] = (bf16_t)(vw[e] >> 16); }
        }
    }
    __syncthreads();
    const int hq = kvh * 4 + (wave >> 1); const float sink = p.in[11][l * 8 + hq];
    for (int ai = 0; ai < 4; ++ai) { const int a = (wave & 1) * 4 + ai;
        const int pos = nb * 128 + 16 * a + c; const size_t tok = (size_t)b * SEQL + pos;
        float q[16]; unpack8(*(const u32x4*)(A + tok * 768 + hq * 64 + 8 * g), q); unpack8(*(const u32x4*)(A + tok * 768 + hq * 64 + 32 + 8 * g), q + 8);
        float ss = 0.f;
#pragma unroll
        for (int e = 0; e < 16; ++e) ss += q[e] * q[e];
        ss += __shfl_xor(ss, 16); ss += __shfl_xor(ss, 32);
        const float r = rsqrtf(ss * (1.f / 64.f) + EPSF);
#pragma unroll
        for (int e = 0; e < 8; ++e) { q[e] = q[e] * r * qn[8 * g + e]; q[8 + e] = q[8 + e] * r * qn[32 + 8 * g + e]; }
        float part[8];
#pragma unroll
        for (int e = 0; e < 8; ++e) part[e] = __shfl_xor(q[e], 16);
        if (g < 2) {
#pragma unroll
            for (int e = 0; e < 8; ++e) { const float cs = TA[(pos * 8 + e) * 2], sn = TA[(pos * 8 + e) * 2 + 1];
                q[e] = (g == 0) ? (q[e] * cs - part[e] * sn) : (q[e] * cs + part[e] * sn); } }
        bf16x8 qb[2];
        { u32x4 w0, w1; w0.x = pk2(q[0] * .125f, q[1] * .125f); w0.y = pk2(q[2] * .125f, q[3] * .125f); w0.z = pk2(q[4] * .125f, q[5] * .125f); w0.w = pk2(q[6] * .125f, q[7] * .125f);
          w1.x = pk2(q[8] * .125f, q[9] * .125f); w1.y = pk2(q[10] * .125f, q[11] * .125f); w1.z = pk2(q[12] * .125f, q[13] * .125f); w1.w = pk2(q[14] * .125f, q[15] * .125f);
          qb[0] = __builtin_bit_cast(bf16x8, w0); qb[1] = __builtin_bit_cast(bf16x8, w1); }
        f32x4 P[10]; float mx = sink;
#pragma unroll
        for (int jp = 0; jp < 9; ++jp) { const int jt = a + jp;
            const bf16x8 k0 = *(const bf16x8*)(KS + (16 * jt + c) * 72 + 8 * g), k1 = *(const bf16x8*)(KS + (16 * jt + c) * 72 + 32 + 8 * g);
            f32x4 t = (f32x4){zz, zz, zz, zz}; t = MFMA16(k0, qb[0], t); t = MFMA16(k1, qb[1], t);
#pragma unroll
            for (int rr = 0; rr < 4; ++rr) { const int kj = 16 * jt + 4 * g + rr, qi = 16 * a + c; const bool ok = (kj > qi) && (kj <= qi + 128) && (nb > 0 || kj >= 128);
                t[rr] = ok ? t[rr] : -1e30f; mx = fmaxf(mx, t[rr]); }
            P[jp] = t; }
        P[9] = (f32x4){zz, zz, zz, zz};
        mx = fmaxf(mx, __shfl_xor(mx, 16)); mx = fmaxf(mx, __shfl_xor(mx, 32));
        float sum = 0.f;
#pragma unroll
        for (int jp = 0; jp < 9; ++jp)
#pragma unroll
            for (int rr = 0; rr < 4; ++rr) { const float e = __expf(P[jp][rr] - mx); P[jp][rr] = e; sum += e; }
        sum += __shfl_xor(sum, 16); sum += __shfl_xor(sum, 32);
        const float inv = 1.f / (sum + __expf(sink - mx));
#pragma unroll
        for (int jp = 0; jp < 9; ++jp) P[jp] = P[jp] * inv;
        f32x4 o[4];
#pragma unroll
        for (int nt = 0; nt < 4; ++nt) o[nt] = (f32x4){zz, zz, zz, zz};
#pragma unroll
        for (int s = 0; s < 5; ++s) { const bf16x8 pa = pack8(P[2 * s], P[2 * s + 1]);
#pragma unroll
            for (int nt = 0; nt < 4; ++nt) { const bf16_t* vp = VT + (16 * nt + c) * 264 + 16 * (a + 2 * s) + 4 * g;
                const u32x2 lo = *(const u32x2*)vp; const u32x2 hi = (s < 4) ? *(const u32x2*)(vp + 16) : (u32x2){zu, zu};
                o[nt] = MFMA16(pa, cat8(lo, hi), o[nt]); } }
#pragma unroll
        for (int nt = 0; nt < 4; ++nt)
#pragma unroll
            for (int rr = 0; rr < 4; ++rr) { const size_t tk = (size_t)b * SEQL + nb * 128 + 16 * a + 4 * g + rr; BRA[tk * 512 + hq * 64 + 16 * nt + c] = (bf16_t)f2bf(o[nt][rr]); }
    }
    __syncthreads();
}
constexpr int N_PHASES = 25;
#ifndef COOP
#define COOP 1
#endif
DI void fast_grid_barrier(unsigned* ctr, unsigned target) {
    asm volatile("s_waitcnt vmcnt(0)" ::: "memory");
    __syncthreads();
    if (threadIdx.x == 0) {
        __builtin_amdgcn_fence(__ATOMIC_RELEASE, "agent");
        asm volatile("s_waitcnt vmcnt(0)" ::: "memory");
        __hip_atomic_fetch_add(ctr, 1u, __ATOMIC_RELAXED, __HIP_MEMORY_SCOPE_AGENT);
        while (__hip_atomic_load(ctr, __ATOMIC_RELAXED, __HIP_MEMORY_SCOPE_AGENT) < target) __builtin_amdgcn_s_sleep(1);
        __builtin_amdgcn_fence(__ATOMIC_ACQUIRE, "agent");
        asm volatile("s_waitcnt vmcnt(0)" ::: "memory");
    }
    __syncthreads();
}
__global__ void __launch_bounds__(512, 2) mega_fwd(Params p) {
    extern __shared__ __attribute__((aligned(16))) unsigned char lds_raw[];
    const int G0 = gridDim.x, bx0 = blockIdx.x, wv0 = __builtin_amdgcn_readfirstlane((int)(threadIdx.x >> 6)); unsigned nbar = 0;
#ifndef REP_S
#define REP_S -1
#define REP_N 0
#endif
#ifndef REP_L
#define REP_L -1
#endif
    for (int phx = p.ph_lo * (1 + REP_N); phx < p.ph_hi * (1 + REP_N); ++phx) {
        const int ph = phx / (1 + REP_N);
        if (REP_N > 0 && (phx % (1 + REP_N)) != 0 && !(ph > 0 && (ph - 1) % 12 == REP_S && (REP_L < 0 || (ph - 1) / 12 == REP_L))) continue;
        if (phx > p.ph_lo * (1 + REP_N)) {
            if (phx == p.ph_lo * (1 + REP_N) + 1) cg::this_grid().sync();
            else { ++nbar; fast_grid_barrier((unsigned*)(p.ws + OFF_CTR), nbar * (unsigned)G0); }
        }
#ifdef SYNC_ONLY
        if ((phx % (1 + REP_N)) != 0) continue;
#endif
        typedef __attribute__((address_space(4))) const Params* KP;
        KP kp = (KP)__builtin_amdgcn_kernarg_segment_ptr();
        int wvi = wv0; asm volatile("" : "+s"(wvi));
        unsigned ones = ~0u; asm volatile("" : "+s"(ones));
        int tid = wvi * 64 + (int)__builtin_amdgcn_mbcnt_hi(ones, __builtin_amdgcn_mbcnt_lo(ones, 0u)), G = G0, bx = bx0;
        asm volatile("" : "+v"(tid), "+s"(G), "+s"(bx), "+s"(kp) :: "memory");
        const Params& P = *(const Params*)kp; unsigned char* ws = P.ws;
        PG8_LAS unsigned char* ldsl = (PG8_LAS unsigned char*)lds_raw; asm volatile("" : "+v"(ldsl));
        unsigned char* lds = (unsigned char*)ldsl;
        float* MOD = (float*)(ws + OFF_MOD);
        if (ph == 0) { phase_mod(P, lds, tid); continue; }
        const int q = ph - 1, l = q / 12, s = q % 12;
        const float* xsrc = (l == 0 && s <= 2) ? P.in[0] : P.out;
        float* modl = MOD + (size_t)l * 8 * NMODW;
        if (s == 0 || s == 3 || s == 9) { phase_prep(P, l, s == 0 ? 0 : (s == 3 ? 1 : 2), xsrc, lds, tid, !(s == 9 && G > 192)); }
        else if (s == 1 || s == 10) {
            pg8::Gemm g{(const bf16_t*)(ws + OFF_U), (const bf16_t*)(ws + OFF_W13T), MT, 2 * DFF, DM}; pg8::StaticOrder S; S.init(MT, 2 * DFF, G, bx);
            EpiSwiGLU E{(bf16_t*)(ws + OFF_H)};
            pg8::gemm_phase<EpiSwiGLU, pg8::StaticOrder, true, true>(ldsl, g, S, E, tid);
        } else if (s == 2 || s == 8 || s == 11) {
            pg8::Gemm g{(const bf16_t*)(ws + (s == 8 ? OFF_U : OFF_H)), (const bf16_t*)(ws + (s == 8 ? OFF_WOT : OFF_W2T)), MT, DM, s == 8 ? DM : DFF}; pg8::StaticOrder S; S.init(MT, DM, G, bx);
            EpiResid E{xsrc, P.out, modl + (s == 2 ? 2 : (s == 8 ? 5 : 8)) * DM, s == 8 ? 1.f : 0.5f};
            pg8::gemm_phase<EpiResid, pg8::StaticOrder, false, true>(ldsl, g, S, E, tid);
        } else if (s == 4) {
            pg8::Gemm g{(const bf16_t*)(ws + OFF_U), (const bf16_t*)(ws + OFF_WINT), MT, NPROJ, DM}; pg8::StaticOrder S; S.init(MT, NPROJ, G, bx);
            EpiProj E{ws};
            pg8::gemm_phase<EpiProj, pg8::StaticOrder, true, true>(ldsl, g, S, E, tid);
        } else if (s == 5) {
            { u32x4 pre[12]; dn_prep_fetch(P, bx < 2048 ? bx : 0, tid, pre);
              for (int it = bx; it < 2048; it += G) { int tl = tid; asm volatile("" : "+v"(tl)); dn_prep_item(P, l, it, it + G, pre, lds, tl); } }
        } else if (s == 6) {
            const int stride = (G > 192) ? ((bx < 128) ? (1 << 20) : (G - 128)) : G;
            for (int it = bx; it < 384; it += stride) {
                int tl = tid; asm volatile("" : "+v"(tl));
#ifdef ROLE_ONLY
                if ((phx % (1 + REP_N)) != 0 && (it < 64 ? 0 : (it < 128 ? 1 : 2)) != ROLE_ONLY) continue;
#endif
                if (it < 64) dn_scan_wg(P, l, it, lds, tl);
                else if (it < 128) ret_scan_wg(P, l, it - 64, lds, tl);
                else attn_item(P, l, it - 128, lds, tl);
                __syncthreads();
            }
            if (G > 192 && (bx < 64 || bx >= 128)) {
                const int cw = (bx < 64) ? bx : bx - 64; convert_ffn(P, l, 2, lds, tid, cw * 8 + (tid >> 6), (G - 64) * 8); }
        } else if (s == 7) {
            pg8::Gemm g{(const bf16_t*)(ws + OFF_DQKV), (const bf16_t*)(ws + OFF_WBT), 3 * MT, 3 * DM, 512}; MergeOrder S{G, bx};
            EpiMerge E{(const bf16_t*)(ws + OFF_GATES), (bf16_t*)(ws + OFF_U)};
            pg8::gemm_phase<EpiMerge, MergeOrder, true, true>(ldsl, g, S, E, tid);
        }
    }
}

extern "C" void kernel_launch(void* const* d_in, const int* in_sizes, int n_in, void* d_out, int out_size, void* d_ws, size_t ws_size, hipStream_t stream) {
    static int grid = 0;
    if (grid == 0) {
        int dev = 0, cus = 0, per_cu = 0;
        hipGetDevice(&dev); hipDeviceGetAttribute(&cus, hipDeviceAttributeMultiprocessorCount, dev);
        hipFuncSetAttribute((const void*)mega_fwd, hipFuncAttributeMaxDynamicSharedMemorySize, LDS_BYTES);
        hipOccupancyMaxActiveBlocksPerMultiprocessor(&per_cu, (const void*)mega_fwd, 512, LDS_BYTES);
        if (per_cu < 1) per_cu = 1;
        grid = cus * per_cu; if (grid > 256) grid = 256;
        if (ws_size < WS_END) fprintf(stderr, "kernel_launch: workspace too small: %zu < %zu\n", ws_size, (size_t)WS_END);
        (void)hipGetLastError();
    }
    hipMemsetAsync((unsigned char*)d_ws + OFF_CTR, 0, 256, stream);
    Params p{};
    for (int i = 0; i < 21; ++i) p.in[i] = (const float*)d_in[i];
    p.out = (float*)d_out; p.ws = (unsigned char*)d_ws;
#if COOP
    p.ph_lo = 0; p.ph_hi = N_PHASES;
    void* args[] = {&p};
    hipError_t e = hipLaunchCooperativeKernel((const void*)mega_fwd, dim3(grid), dim3(512), args, LDS_BYTES, stream);
    if (e != hipSuccess) fprintf(stderr, "cooperative launch failed: %s (grid %d)\n", hipGetErrorString(e), grid);
#else
    for (int ph = 0; ph < N_PHASES; ++ph) { p.ph_lo = ph; p.ph_hi = ph + 1; hipLaunchKernelGGL(mega_fwd, dim3(grid), dim3(512), LDS_BYTES, stream, p); }
#endif
}
```
